# Optimizing an MI355X kernel written in HIP

```python
import math
import jax
import jax.numpy as jnp
from jax import lax
import numpy as np

D_MODEL = 1024
BATCH = 4
SEQ = 4096
DEPTH = 2

SSD_HEADS = 16
SSD_HEAD_DIM = 64
SSD_INNER = SSD_HEADS * SSD_HEAD_DIM
SSD_GROUPS = 2
SSD_STATE = 128
SSD_CONV = 4
SSD_CHUNK = 128
SSD_CONV_CH = SSD_INNER + 2 * SSD_GROUPS * SSD_STATE
DT_MIN = 1e-3
DT_MAX = 1e-1

SGU_WIDTH = 1024
SGU_GROUPS = 8
SGU_GROUP_DIM = SGU_WIDTH // SGU_GROUPS
SGU_CHUNK = 128

MLA_HEADS = 16
MLA_Q_RANK = 256
MLA_KV_RANK = 128
MLA_NOPE = 64
MLA_ROPE = 32
MLA_V = 64
MLA_QK = MLA_NOPE + MLA_ROPE
MLA_WIDTH = MLA_HEADS * MLA_V
ATTN_BLOCK = 128
ROPE_BASE = 10000.0

N_BRANCH = 3
IN_SSD = 2 * SSD_INNER + 2 * SSD_GROUPS * SSD_STATE + SSD_HEADS
IN_SGU = 2 * SGU_WIDTH
IN_MLA = MLA_Q_RANK + MLA_KV_RANK + MLA_ROPE
IN_GATE = N_BRANCH * D_MODEL
N_IN = IN_SSD + IN_SGU + IN_MLA + IN_GATE

FFN_DENSE = 2816
N_EXPERTS = 8
TOP_K = 2
FFN_EXPERT = 3584
N_DENSE = (DEPTH + 1) // 2
N_MOE = DEPTH // 2

EPS = 1e-6
LN_EPS = 1e-5

kernel_name = 'hybrid_ssd_sgu_mla_moe_block'


def rms_norm(x, g, eps=EPS):
    xf = x.astype(jnp.float32)
    y = xf * lax.rsqrt(jnp.mean(xf * xf, axis=-1, keepdims=True) + eps)
    return (y * g.astype(jnp.float32)).astype(x.dtype)


def layer_norm(x, g, b, eps=LN_EPS):
    xf = x.astype(jnp.float32)
    mu = jnp.mean(xf, axis=-1, keepdims=True)
    xc = xf - mu
    y = xc * lax.rsqrt(jnp.mean(xc * xc, axis=-1, keepdims=True) + eps)
    return (y * g.astype(jnp.float32) + b.astype(jnp.float32)).astype(x.dtype)


def causal_depthwise_conv(x, w, b):
    ch = x.shape[-1]
    y = lax.conv_general_dilated(
        x, w[:, None, :].astype(x.dtype), window_strides=(1,),
        padding=[(SSD_CONV - 1, 0)], dimension_numbers=('NWC', 'WIO', 'NWC'),
        feature_group_count=ch)
    return y + b.astype(x.dtype)


def segsum_exp(a):
    l = a.shape[-1]
    cs = jnp.cumsum(a, axis=-1)
    diff = cs[..., :, None] - cs[..., None, :]
    mask = jnp.tril(jnp.ones((l, l), dtype=bool))
    return jnp.where(mask, jnp.exp(jnp.where(mask, diff, 0.0)), 0.0)


def ssd_scan(x, dt, a, b, c):
    bsz, s, h, p = x.shape
    g, n = b.shape[-2], b.shape[-1]
    k = h // g
    l = SSD_CHUNK
    nc = s // l
    xs = (x * dt[..., None]).reshape(bsz, nc, l, g, k, p)
    adt = jnp.moveaxis((dt * a).reshape(bsz, nc, l, g, k), 2, -1)
    a_cs = jnp.cumsum(adt, axis=-1)
    bc = b.reshape(bsz, nc, l, g, n)
    cc = c.reshape(bsz, nc, l, g, n)
    decay = segsum_exp(adt)
    cb = jnp.einsum('bclgn,bcsgn->bcgls', cc, bc)
    y_diag = jnp.einsum('bcgls,bcgkls,bcsgkp->bclgkp', cb, decay, xs)
    decay_states = jnp.exp(a_cs[..., -1:] - a_cs)
    states = jnp.einsum('bclgn,bcgkl,bclgkp->bcgkpn', bc, decay_states, xs)
    chunk_decay = jnp.exp(a_cs[..., -1])

    def step(carry, inp):
        st, dec = inp
        return carry * dec[..., None, None] + st, carry

    init = jnp.zeros((bsz, g, k, p, n), x.dtype)
    _, prev = lax.scan(step, init, (jnp.moveaxis(states, 1, 0), jnp.moveaxis(chunk_decay, 1, 0)))
    prev = jnp.moveaxis(prev, 0, 1)
    y_off = jnp.einsum('bclgn,bcgkpn,bcgkl->bclgkp', cc, prev, jnp.exp(a_cs))
    return (y_diag + y_off).reshape(bsz, s, h, p)


def ssd_branch(zxbcdt, conv_w, conv_b, dt_bias, a_log, d_skip, norm_g):
    bsz, s, _ = zxbcdt.shape
    f32 = jnp.float32
    z, xbc, dt = jnp.split(zxbcdt, [SSD_INNER, SSD_INNER + SSD_CONV_CH], axis=-1)
    xbc = jax.nn.silu(causal_depthwise_conv(xbc, conv_w, conv_b))
    xh, bm, cm = jnp.split(xbc, [SSD_INNER, SSD_INNER + SSD_GROUPS * SSD_STATE], axis=-1)
    xh = xh.reshape(bsz, s, SSD_HEADS, SSD_HEAD_DIM).astype(f32)
    bm = bm.reshape(bsz, s, SSD_GROUPS, SSD_STATE).astype(f32)
    cm = cm.reshape(bsz, s, SSD_GROUPS, SSD_STATE).astype(f32)
    dt = jax.nn.softplus(dt.astype(f32) + dt_bias.astype(f32))
    a = -jnp.exp(a_log.astype(f32))
    y = ssd_scan(xh, dt, a, bm, cm) + xh * d_skip.astype(f32)[:, None]
    yg = (y.reshape(bsz, s, SSD_INNER) * jax.nn.silu(z.astype(f32)))
    yg = yg.reshape(bsz, s, SSD_GROUPS, SSD_INNER // SSD_GROUPS)
    yg = yg * lax.rsqrt(jnp.mean(yg * yg, axis=-1, keepdims=True) + EPS)
    return (yg.reshape(bsz, s, SSD_INNER) * norm_g.astype(f32)).astype(zxbcdt.dtype)


def sgu_branch(uv, ln_g, ln_b, w_s, b_s):
    bsz, s, _ = uv.shape
    uv = jax.nn.gelu(uv, approximate=False)
    u, v = jnp.split(uv, 2, axis=-1)
    v = layer_norm(v, ln_g, ln_b)
    nc = s // SGU_CHUNK
    v = v.reshape(bsz, nc, SGU_CHUNK, SGU_GROUPS, SGU_GROUP_DIM)
    w = w_s * jnp.tril(jnp.ones((SGU_CHUNK, SGU_CHUNK), w_s.dtype))
    mixed = jnp.einsum('gts,bcsgd->bctgd', w, v) + jnp.swapaxes(b_s, 0, 1)[None, None, :, :, None]
    return u * mixed.reshape(bsz, s, SGU_WIDTH)


def rope_tables(s, dim):
    inv = 1.0 / (ROPE_BASE ** (jnp.arange(0, dim, 2, dtype=jnp.float32) / dim))
    ang = jnp.arange(s, dtype=jnp.float32)[:, None] * inv[None, :]
    return jnp.cos(ang), jnp.sin(ang)


def apply_rope(x, cos, sin):
    x1, x2 = jnp.split(x.astype(jnp.float32), 2, axis=-1)
    c = cos[None, :, None, :]
    sn = sin[None, :, None, :]
    return jnp.concatenate([x1 * c - x2 * sn, x1 * sn + x2 * c], axis=-1).astype(x.dtype)


def causal_attention(q, k, v):
    bsz, s, h, dq = q.shape
    nb = s // ATTN_BLOCK
    scale = dq ** -0.5
    qb = jnp.moveaxis(q.reshape(bsz, nb, ATTN_BLOCK, h, dq), 1, 0)
    k_pos = jnp.arange(s)

    def one_block(args):
        qi, start = args
        sc = jnp.einsum('bqhd,bkhd->bhqk', qi, k).astype(jnp.float32) * scale
        q_pos = start + jnp.arange(ATTN_BLOCK)
        mask = k_pos[None, :] <= q_pos[:, None]
        p = jax.nn.softmax(jnp.where(mask, sc, -jnp.inf), axis=-1)
        return jnp.einsum('bhqk,bkhd->bqhd', p.astype(v.dtype), v)

    out = lax.map(one_block, (qb, jnp.arange(nb) * ATTN_BLOCK))
    return jnp.moveaxis(out, 0, 1).reshape(bsz, s, h, v.shape[-1])


def mla_branch(lat, q_norm_g, w_uq, kv_norm_g, w_ukv, q_head_g, k_head_g):
    bsz, s, _ = lat.shape
    q_lat, kv_lat, k_pe = jnp.split(lat, [MLA_Q_RANK, MLA_Q_RANK + MLA_KV_RANK], axis=-1)
    q = (rms_norm(q_lat, q_norm_g) @ w_uq).reshape(bsz, s, MLA_HEADS, MLA_QK)
    kv = (rms_norm(kv_lat, kv_norm_g) @ w_ukv).reshape(bsz, s, MLA_HEADS, MLA_NOPE + MLA_V)
    k_nope, v = jnp.split(kv, [MLA_NOPE], axis=-1)
    k_pe_h = jnp.broadcast_to(k_pe[:, :, None, :], (bsz, s, MLA_HEADS, MLA_ROPE))
    k = jnp.concatenate([k_nope, k_pe_h], axis=-1)
    q = rms_norm(q, q_head_g)
    k = rms_norm(k, k_head_g)
    cos, sin = rope_tables(s, MLA_ROPE)
    q = jnp.concatenate([q[..., :MLA_NOPE], apply_rope(q[..., MLA_NOPE:], cos, sin)], axis=-1)
    k = jnp.concatenate([k[..., :MLA_NOPE], apply_rope(k[..., MLA_NOPE:], cos, sin)], axis=-1)
    out = causal_attention(q, k, v)
    return out.reshape(bsz, s, MLA_WIDTH)


def swiglu(x, wg, wu, wd):
    return (jax.nn.silu(x @ wg) * (x @ wu)) @ wd


def moe_ffn(x, router_w, wg, wu, wd):
    bsz, s, d = x.shape
    t = x.reshape(-1, d)
    logits = (t @ router_w).astype(jnp.float32)
    top_v, top_i = lax.top_k(logits, TOP_K)
    top_w = jax.nn.softmax(top_v, axis=-1)
    combine = jnp.sum(jax.nn.one_hot(top_i, N_EXPERTS, dtype=jnp.float32) * top_w[..., None], axis=1)
    y = jnp.zeros_like(t)
    for e in range(N_EXPERTS):
        y = y + combine[:, e:e + 1].astype(t.dtype) * swiglu(t, wg[e], wu[e], wd[e])
    return y.reshape(bsz, s, d)


def setup_inputs(seed: int = 0) -> dict:
    key = jax.random.key(seed)
    keys = iter(jax.random.split(key, 48))
    f32 = jnp.float32

    def normal(shape, scale):
        return jax.random.normal(next(keys), shape, f32) * scale

    def gain(shape):
        return 1.0 + 0.02 * jax.random.normal(next(keys), shape, f32)

    L = DEPTH
    dt = jnp.exp(jax.random.uniform(next(keys), (L, SSD_HEADS), f32, math.log(DT_MIN), math.log(DT_MAX)))
    inputs = {}
    inputs['x'] = normal((BATCH, SEQ, D_MODEL), 1.0)
    inputs['mix_norm_g'] = gain((L, D_MODEL))
    inputs['w_in'] = normal((L, D_MODEL, N_IN), D_MODEL ** -0.5)
    inputs['conv_w'] = normal((L, SSD_CONV, SSD_CONV_CH), SSD_CONV ** -0.5)
    inputs['conv_b'] = normal((L, SSD_CONV_CH), 0.02)
    inputs['dt_bias'] = dt + jnp.log(-jnp.expm1(-dt))
    inputs['a_log'] = jnp.log(jax.random.uniform(next(keys), (L, SSD_HEADS), f32, 1.0, 16.0))
    inputs['d_skip'] = gain((L, SSD_HEADS))
    inputs['ssd_norm_g'] = gain((L, SSD_INNER))
    inputs['sgu_ln_g'] = gain((L, SGU_WIDTH))
    inputs['sgu_ln_b'] = normal((L, SGU_WIDTH), 0.02)
    inputs['sgu_w'] = normal((L, SGU_GROUPS, SGU_CHUNK, SGU_CHUNK), SGU_CHUNK ** -0.5)
    inputs['sgu_b'] = gain((L, SGU_GROUPS, SGU_CHUNK))
    inputs['q_norm_g'] = gain((L, MLA_Q_RANK))
    inputs['w_uq'] = normal((L, MLA_Q_RANK, MLA_HEADS * MLA_QK), MLA_Q_RANK ** -0.5)
    inputs['kv_norm_g'] = gain((L, MLA_KV_RANK))
    inputs['w_ukv'] = normal((L, MLA_KV_RANK, MLA_HEADS * (MLA_NOPE + MLA_V)), MLA_KV_RANK ** -0.5)
    inputs['q_head_g'] = gain((L, MLA_QK))
    inputs['k_head_g'] = gain((L, MLA_QK))
    inputs['w_br_ssd'] = normal((L, SSD_INNER, D_MODEL), SSD_INNER ** -0.5)
    inputs['w_br_sgu'] = normal((L, SGU_WIDTH, D_MODEL), SGU_WIDTH ** -0.5)
    inputs['w_br_mla'] = normal((L, MLA_WIDTH, D_MODEL), MLA_WIDTH ** -0.5)
    inputs['w_out'] = normal((L, D_MODEL, D_MODEL), D_MODEL ** -0.5)
    inputs['ffn_norm_g'] = gain((L, D_MODEL))
    inputs['ffn_w_gate'] = normal((N_DENSE, D_MODEL, FFN_DENSE), D_MODEL ** -0.5)
    inputs['ffn_w_up'] = normal((N_DENSE, D_MODEL, FFN_DENSE), D_MODEL ** -0.5)
    inputs['ffn_w_down'] = normal((N_DENSE, FFN_DENSE, D_MODEL), FFN_DENSE ** -0.5)
    inputs['router_w'] = normal((N_MOE, D_MODEL, N_EXPERTS), D_MODEL ** -0.5)
    inputs['moe_w_gate'] = normal((N_MOE, N_EXPERTS, D_MODEL, FFN_EXPERT), D_MODEL ** -0.5)
    inputs['moe_w_up'] = normal((N_MOE, N_EXPERTS, D_MODEL, FFN_EXPERT), D_MODEL ** -0.5)
    inputs['moe_w_down'] = normal((N_MOE, N_EXPERTS, FFN_EXPERT, D_MODEL), FFN_EXPERT ** -0.5)
    return inputs


def reference(x, mix_norm_g, w_in, conv_w, conv_b, dt_bias, a_log, d_skip, ssd_norm_g,
              sgu_ln_g, sgu_ln_b, sgu_w, sgu_b, q_norm_g, w_uq, kv_norm_g, w_ukv,
              q_head_g, k_head_g, w_br_ssd, w_br_sgu, w_br_mla, w_out, ffn_norm_g,
              ffn_w_gate, ffn_w_up, ffn_w_down, router_w, moe_w_gate, moe_w_up, moe_w_down):
    for i in range(DEPTH):
        h = rms_norm(x, mix_norm_g[i])
        proj = h @ w_in[i]
        p_ssd, p_sgu, p_mla, p_gate = jnp.split(
            proj, [IN_SSD, IN_SSD + IN_SGU, IN_SSD + IN_SGU + IN_MLA], axis=-1)
        y_ssd = ssd_branch(p_ssd, conv_w[i], conv_b[i], dt_bias[i], a_log[i], d_skip[i], ssd_norm_g[i])
        y_sgu = sgu_branch(p_sgu, sgu_ln_g[i], sgu_ln_b[i], sgu_w[i], sgu_b[i])
        y_mla = mla_branch(p_mla, q_norm_g[i], w_uq[i], kv_norm_g[i], w_ukv[i], q_head_g[i], k_head_g[i])
        g_ssd, g_sgu, g_mla = jnp.split(jax.nn.sigmoid(p_gate), N_BRANCH, axis=-1)
        merged = (g_ssd * (y_ssd @ w_br_ssd[i])
                  + g_sgu * (y_sgu @ w_br_sgu[i])
                  + g_mla * (y_mla @ w_br_mla[i]))
        x = x + merged @ w_out[i]
        h = rms_norm(x, ffn_norm_g[i])
        j = i // 2
        if i % 2 == 0:
            x = x + swiglu(h, ffn_w_gate[j], ffn_w_up[j], ffn_w_down[j])
        else:
            x = x + moe_ffn(h, router_w[j], moe_w_gate[j], moe_w_up[j], moe_w_down[j])
    return x
```

```cpp
#include <hip/hip_runtime.h>
#include <cstdio>
#include <cstdint>
namespace pg8 {
#define PG8_LAS __attribute__((address_space(3)))
typedef unsigned short bf16_t;
typedef short bf16x8 __attribute__((ext_vector_type(8)));
typedef float f32x4 __attribute__((ext_vector_type(4)));
typedef unsigned u32x4 __attribute__((ext_vector_type(4)));
constexpr int BM = 256, BK = 64, HALF = 128, HTB = HALF * BK * 2  , STAGE_BYTES = 8 * HTB, NXCD = 8, WGM = 8;

__host__ __device__ __forceinline__ int lds_byte(int r, int c) { const int st = (r >> 4) * 2 + (c >> 5), rr = r & 15, cc = c & 31, ob = rr * 64 + cc * 2; return st * 1024 + (ob ^ (((ob >> 9) & 1) << 5)); }
__host__ __device__ __forceinline__ void stage_rc(int b, int& R, int& C) { const int st = b / 1024, sb = b % 1024, swz = sb ^ (((sb >> 9) & 1) << 5); R = (st >> 1) * 16 + swz / 64; C = (st & 1) * 32 + (swz % 64) / 2; }
__host__ __device__ __forceinline__ int perm32(int rho) { const int n = rho >> 4, i = rho & 15; return 8 * (i >> 2) + 4 * n + (i & 3); }

struct Unit { int pm, pn; };
struct Gemm { const bf16_t* A; const bf16_t* Bt; int M, N, K; };

struct StaticOrder {
    int nM, nN, nwg, G, c;
    __host__ __device__ void init(int M, int N, int G_, int c_) { nM = M / BM; nN = N / BM; nwg = nM * nN; G = G_; c = c_; }
    __host__ __device__ bool next(int i, Unit& u) const {
        const long L = (long)i * G + c; if (L >= nwg) return false;
        int wgid = (int)L; { const int q = nwg / NXCD, r = nwg % NXCD, xcd = wgid % NXCD, off = wgid / NXCD; wgid = (xcd < r ? xcd * (q + 1) : r * (q + 1) + (xcd - r) * q) + off; }
        const int nig = WGM * nN, gid = wgid / nig, fm = gid * WGM, gsz = (nM - fm) < WGM ? (nM - fm) : WGM;
        u.pm = fm + ((wgid % nig) % gsz); u.pn = (wgid % nig) / gsz; return true;
    }
    __device__ __forceinline__ void a_ready(const Unit&) const {}
    __device__ __forceinline__ size_t b_off(const Unit&) const { return 0; }
    __device__ __forceinline__ void done(const Unit&) const {}
};

__device__ __forceinline__ unsigned cvt_pk_bf16(float lo, float hi) { unsigned r; asm volatile("v_cvt_pk_bf16_f32 %0, %1, %2" : "=v"(r) : "v"(lo), "v"(hi)); return r; }
typedef float f32x2 __attribute__((ext_vector_type(2)));
__device__ __forceinline__ f32x2 gelu_pk(f32x2 v) {
    const f32x2 av = __builtin_elementwise_abs(v), d = av * 0.2316418882f + 1.0f;
    f32x2 t; t.x = __builtin_amdgcn_rcpf(d.x); t.y = __builtin_amdgcn_rcpf(d.y);
    f32x2 q = t * 0.5307027145f + (-0.7265760135f); q = q * t + 0.7107068705f; q = q * t + (-0.142248368f); q = q * t + 0.127414796f; q = q * t;
    const f32x2 s = (v * v) * (-0.72134752044f);
    f32x2 e; e.x = __builtin_amdgcn_exp2f(s.x); e.y = __builtin_amdgcn_exp2f(s.y);
    const f32x2 m = v * (q * e), r = v - m;
    f32x2 o; o.x = v.x < 0.f ? m.x : r.x; o.y = v.y < 0.f ? m.y : r.y; return o;
}

__device__ __forceinline__ unsigned pkbf(float lo, float hi) { typedef __bf16 b2_t __attribute__((ext_vector_type(2))); f32x2 v = {lo, hi}; b2_t b = __builtin_convertvector(v, b2_t); return __builtin_bit_cast(unsigned, b); }
__device__ __forceinline__ float bflo(unsigned w) { return __uint_as_float(w << 16); }
__device__ __forceinline__ float bfhi(unsigned w) { return __uint_as_float(w & 0xffff0000u); }
__device__ __forceinline__ float fsigmoid(float x) { return __builtin_amdgcn_rcpf(1.0f + __builtin_amdgcn_exp2f(-1.4426950408889634f * x)); }
template <int ACT> __device__ __forceinline__ f32x4 act4(f32x4 v) {
    if (ACT == 1) { v[0] *= fsigmoid(v[0]); v[1] *= fsigmoid(v[1]); v[2] *= fsigmoid(v[2]); v[3] *= fsigmoid(v[3]); }
    if (ACT == 2) { const f32x2 a = gelu_pk((f32x2){v[0], v[1]}), b = gelu_pk((f32x2){v[2], v[3]}); v = (f32x4){a.x, a.y, b.x, b.y}; }
    if (ACT == 3) { v[0] = fsigmoid(v[0]); v[1] = fsigmoid(v[1]); v[2] = fsigmoid(v[2]); v[3] = fsigmoid(v[3]); }
    return v;
}
template <int ACT> __device__ __forceinline__ void store_tile_bf16(const f32x4 (&acc)[2][2][4][2], bf16_t* base, int ld, int row0, int col0) {
#pragma unroll
    for (int ai = 0; ai < 2; ++ai)
#pragma unroll
        for (int m = 0; m < 4; ++m) { bf16_t* rowp = base + (size_t)(row0 + ai * HALF + m * 16) * ld + col0;
#pragma unroll
            for (int bj = 0; bj < 2; ++bj) { const f32x4 v0 = act4<ACT>(acc[ai][bj][m][0]), v1 = act4<ACT>(acc[ai][bj][m][1]);
                u32x4 w; w.x = pkbf(v0[0], v0[1]); w.y = pkbf(v0[2], v0[3]); w.z = pkbf(v1[0], v1[1]); w.w = pkbf(v1[2], v1[3]);
                *(u32x4*)(rowp + bj * HALF) = w; } }
}
struct EpiIn {
    static constexpr bool PERM = true, AFTER_DRAIN = false;
    bf16_t *Z, *XBC, *QLAT, *U, *V, *GATES; float* MISC; int pn_base;
    __device__ __forceinline__ void operator()(const f32x4 (&acc)[2][2][4][2], const Unit& u, int wr, int wc, int fr, int fq) const {
        const int pn = u.pn + pn_base, row0 = u.pm * BM + wr * 64 + fr, cw = wc * 32 + 8 * fq;
        if (pn < 4) store_tile_bf16<1>(acc, Z, 1024, row0, pn * 256 + cw);
        else if (pn < 10) store_tile_bf16<0>(acc, XBC, 1536, row0, (pn - 4) * 256 + cw);
        else if (pn == 10) {
#pragma unroll
            for (int ai = 0; ai < 2; ++ai)
#pragma unroll
                for (int m = 0; m < 4; ++m) { float* rowp = MISC + (size_t)(row0 + ai * HALF + m * 16) * 256 + cw;
#pragma unroll
                    for (int bj = 0; bj < 2; ++bj) { *(f32x4*)(rowp + bj * HALF) = acc[ai][bj][m][0]; *(f32x4*)(rowp + bj * HALF + 4) = acc[ai][bj][m][1]; } }
        }
        else if (pn == 11) store_tile_bf16<0>(acc, QLAT, 256, row0, cw);
        else if (pn < 16) store_tile_bf16<2>(acc, U, 1024, row0, (pn - 12) * 256 + cw);
        else if (pn < 20) store_tile_bf16<2>(acc, V, 1024, row0, (pn - 16) * 256 + cw);
        else store_tile_bf16<3>(acc, GATES, 3072, row0, (pn - 20) * 256 + cw);
    }
};
struct EpiPlain {
    static constexpr bool PERM = true, AFTER_DRAIN = false;
    bf16_t* O; int ld;
    __device__ __forceinline__ void operator()(const f32x4 (&acc)[2][2][4][2], const Unit& u, int wr, int wc, int fr, int fq) const {
        store_tile_bf16<0>(acc, O, ld, u.pm * BM + wr * 64 + fr, u.pn * BM + wc * 32 + 8 * fq);
    }
};
struct EpiGate {
    static constexpr bool PERM = true, AFTER_DRAIN = false;
    bf16_t* MG; const bf16_t* GATES; int goff; int mode;
    __device__ __forceinline__ void operator()(const f32x4 (&acc)[2][2][4][2], const Unit& u, int wr, int wc, int fr, int fq) const {
        const int row0 = u.pm * BM + wr * 64 + fr, col0 = u.pn * BM + wc * 32 + 8 * fq;
#pragma unroll
        for (int ai = 0; ai < 2; ++ai)
#pragma unroll
            for (int m = 0; m < 4; ++m) { const size_t r = (size_t)(row0 + ai * HALF + m * 16);
#pragma unroll
                for (int bj = 0; bj < 2; ++bj) { const int c = col0 + bj * HALF;
                    const u32x4 gw = *(const u32x4*)(GATES + r * 3072 + goff + c);
                    f32x4 v0 = acc[ai][bj][m][0], v1 = acc[ai][bj][m][1];
                    v0[0] *= bflo(gw.x); v0[1] *= bfhi(gw.x); v0[2] *= bflo(gw.y); v0[3] *= bfhi(gw.y);
                    v1[0] *= bflo(gw.z); v1[1] *= bfhi(gw.z); v1[2] *= bflo(gw.w); v1[3] *= bfhi(gw.w);
                    u32x4* dst = (u32x4*)(MG + r * 1024 + c);
                    if (mode) { const u32x4 o = *dst;
                        v0[0] += bflo(o.x); v0[1] += bfhi(o.x); v0[2] += bflo(o.y); v0[3] += bfhi(o.y);
                        v1[0] += bflo(o.z); v1[1] += bfhi(o.z); v1[2] += bflo(o.w); v1[3] += bfhi(o.w); }
                    u32x4 w; w.x = pkbf(v0[0], v0[1]); w.y = pkbf(v0[2], v0[3]); w.z = pkbf(v1[0], v1[1]); w.w = pkbf(v1[2], v1[3]);
                    *dst = w; } }
    }
};
struct EpiResid {
    static constexpr bool PERM = true, AFTER_DRAIN = false;
    const float* base; float* out;
    __device__ __forceinline__ void operator()(const f32x4 (&acc)[2][2][4][2], const Unit& u, int wr, int wc, int fr, int fq) const {
        const int row0 = u.pm * BM + wr * 64 + fr, col0 = u.pn * BM + wc * 32 + 8 * fq;
#pragma unroll
        for (int ai = 0; ai < 2; ++ai)
#pragma unroll
            for (int m = 0; m < 4; ++m) { const size_t r = (size_t)(row0 + ai * HALF + m * 16);
#pragma unroll
                for (int bj = 0; bj < 2; ++bj) { const size_t off = r * 1024 + col0 + bj * HALF;
                    const f32x4 b0 = *(const f32x4*)(base + off), b1 = *(const f32x4*)(base + off + 4);
                    *(f32x4*)(out + off) = b0 + acc[ai][bj][m][0]; *(f32x4*)(out + off + 4) = b1 + acc[ai][bj][m][1]; } }
    }
};
struct EpiSwiglu {
    static constexpr bool PERM = true, AFTER_DRAIN = false;
    bf16_t* O; int ld;
    __device__ __forceinline__ void operator()(const f32x4 (&acc)[2][2][4][2], const Unit& u, int wr, int wc, int fr, int fq) const {
        const int row0 = u.pm * BM + wr * 64 + fr, col0 = u.pn * HALF + wc * 32 + 8 * fq;
#pragma unroll
        for (int ai = 0; ai < 2; ++ai)
#pragma unroll
            for (int m = 0; m < 4; ++m) {
                const f32x4 g0 = act4<1>(acc[ai][0][m][0]), g1 = act4<1>(acc[ai][0][m][1]); const f32x4 v0 = g0 * acc[ai][1][m][0], v1 = g1 * acc[ai][1][m][1];
                u32x4 w; w.x = pkbf(v0[0], v0[1]); w.y = pkbf(v0[2], v0[3]); w.z = pkbf(v1[0], v1[1]); w.w = pkbf(v1[2], v1[3]);
                *(u32x4*)(O + (size_t)(row0 + ai * HALF + m * 16) * ld + col0) = w; }
    }
};
struct GateOrder {
    StaticOrder so;
    __device__ __forceinline__ bool next(int i, Unit& u) const { if (i >= 3) return false; Unit b; if (!so.next(0, b)) return false; u.pm = b.pm; u.pn = 4 * i + b.pn; return true; }
    __device__ __forceinline__ void a_ready(const Unit&) const {}
    __device__ __forceinline__ size_t b_off(const Unit&) const { return 0; }
    __device__ __forceinline__ void done(const Unit&) const {}
};
struct MoeOrder {
    StaticOrder so; int toff[9]; size_t estride;
    __device__ __forceinline__ bool next(int i, Unit& u) const { return so.next(i, u); }
    __device__ __forceinline__ void a_ready(const Unit&) const {}
    __device__ __forceinline__ size_t b_off(const Unit& u) const { int e = 0;
#pragma unroll
        for (int k = 1; k < 8; ++k) e += (u.pm >= toff[k]) ? 1 : 0;
        return (size_t)e * estride; }
    __device__ __forceinline__ void done(const Unit&) const {}
};

template <class Epi, class Sched, bool ALIGN_EPI = false, bool SP2 = false>
__device__ __forceinline__ void gemm_phase(PG8_LAS unsigned char* lds, const Gemm g, const Sched& S, const Epi& E) {
    int tid_ = threadIdx.x; asm volatile("" : "+v"(tid_));
    const int tid = tid_, wid = __builtin_amdgcn_readfirstlane(tid >> 6), lane = tid & 63, wr = wid >> 2, wc = wid & 3, fr = lane & 15, fq = lane >> 4;
    const int K = g.K, nt = K / BK;
    unsigned voffA[2], voffB[2];
#pragma unroll
    for (int i = 0; i < 2; ++i) { int R, C; stage_rc(tid * 16 + i * 8192, R, C); const int Rb = Epi::PERM ? ((R & ~31) + perm32(R & 31)) : R;
        voffA[i] = (unsigned)(R * K + C) * 2u; voffB[i] = (unsigned)(Rb * K + C) * 2u; }
    const size_t kstep = (size_t)(BK * 2);
    const size_t hstep = (size_t)HALF * K * 2;
    const size_t tstep = 2 * hstep;
    const unsigned ldsw = (unsigned)wid * 1024u;
    const int aoff = lds_byte(wr * 64 + fr, fq * 8), boff = lds_byte(wc * 32 + fr, fq * 8);
#define PG8_SA(b, h) (((b) * 2 + (h)) * HTB)
#define PG8_SB(b, h) ((4 + (b) * 2 + (h)) * HTB)
#define PG8_STAGE(bufoff, gbase, voff) do { _Pragma("unroll") for (int _i = 0; _i < 2; ++_i) \
        __builtin_amdgcn_global_load_lds((const unsigned*)((const char*)(gbase) + (voff)[_i]), (PG8_LAS unsigned*)(lds + (bufoff) + ldsw + _i * 8192), 16, 0, 0); } while (0)
#define PG8_LDA(dst, b, h) do { _Pragma("unroll") for (int m = 0; m < 4; ++m) _Pragma("unroll") for (int k = 0; k < 2; ++k) dst[m][k] = *(const PG8_LAS bf16x8*)(lds + PG8_SA(b, h) + aoff + m * 2048 + k * 1024); } while (0)
#define PG8_LDB(dst, b, h) do { _Pragma("unroll") for (int n = 0; n < 2; ++n) _Pragma("unroll") for (int k = 0; k < 2; ++k) dst[n][k] = *(const PG8_LAS bf16x8*)(lds + PG8_SB(b, h) + boff + n * 2048 + k * 1024); } while (0)
#define PG8_MMA(ai, bj, At, Bt) do { __builtin_amdgcn_s_setprio(1); _Pragma("unroll") for (int m = 0; m < 4; ++m) _Pragma("unroll") for (int n = 0; n < 2; ++n) _Pragma("unroll") for (int k = 0; k < 2; ++k) \
        acc[ai][bj][m][n] = __builtin_amdgcn_mfma_f32_16x16x32_bf16(Bt[n][k], At[m][k], acc[ai][bj][m][n], 0, 0, 0); __builtin_amdgcn_s_setprio(0); } while (0)
#define PG8_WAIT_V(n) asm volatile("s_waitcnt vmcnt(" #n ")" ::: "memory")
#define PG8_WAIT_L(n) asm volatile("s_waitcnt lgkmcnt(" #n ")" ::: "memory")
#define PG8_BAR __builtin_amdgcn_s_barrier()
#define PG8_SCHED __builtin_amdgcn_sched_barrier(0)
    Unit cur, nxt; int ui = 0;
    if (!S.next(0, cur)) return;
    f32x4 acc[2][2][4][2];
#pragma unroll
    for (int a = 0; a < 2; ++a)
#pragma unroll
        for (int b = 0; b < 2; ++b)
#pragma unroll
            for (int m = 0; m < 4; ++m)
#pragma unroll
                for (int n = 0; n < 2; ++n) acc[a][b][m][n] = (f32x4){0.f, 0.f, 0.f, 0.f};
    bf16x8 At[4][2], B0[2][2], B1[2][2];
    const char* cA = (const char*)g.A + (size_t)cur.pm * tstep; const char* cB = (const char*)g.Bt + S.b_off(cur) + (size_t)cur.pn * tstep;
    S.a_ready(cur);
    if constexpr (SP2) {
        PG8_STAGE(PG8_SB(0, 0), cB, voffB); PG8_STAGE(PG8_SB(0, 1), cB + hstep, voffB); PG8_STAGE(PG8_SA(0, 0), cA, voffA); PG8_STAGE(PG8_SA(0, 1), cA + hstep, voffA);
        if (wr == 1) PG8_BAR;
        PG8_WAIT_V(2); PG8_BAR;
        PG8_STAGE(PG8_SB(1, 0), cB + kstep, voffB); PG8_STAGE(PG8_SA(1, 0), cA + kstep, voffA); PG8_STAGE(PG8_SB(1, 1), cB + hstep + kstep, voffB);
        PG8_WAIT_V(6); PG8_BAR;
    } else {
        PG8_STAGE(PG8_SB(0, 0), cB, voffB); PG8_STAGE(PG8_SA(0, 0), cA, voffA); PG8_STAGE(PG8_SB(0, 1), cB + hstep, voffB); PG8_STAGE(PG8_SA(0, 1), cA + hstep, voffA);
        if (wr == 1) PG8_BAR;
        PG8_WAIT_V(4); PG8_BAR;
        PG8_STAGE(PG8_SB(1, 0), cB + kstep, voffB); PG8_STAGE(PG8_SA(1, 0), cA + kstep, voffA); PG8_STAGE(PG8_SB(1, 1), cB + hstep + kstep, voffB);
        PG8_WAIT_V(6); PG8_BAR;
    }
    for (;;) {
        const bool has_next = S.next(ui + 1, nxt);
        const char* nA = has_next ? (const char*)g.A + (size_t)nxt.pm * tstep : cA; const char* nB = has_next ? (const char*)g.Bt + S.b_off(nxt) + (size_t)nxt.pn * tstep : cB;
        for (int t = 0; t < nt; t += 2) {
            const bool last = (t == nt - 2);
            const char* a1 = cA + (size_t)(t + 1) * kstep;
            const char* a2 = last ? nA : cA + (size_t)(t + 2) * kstep; const char* b2 = last ? nB : cB + (size_t)(t + 2) * kstep;
            const char* a3 = a2 + kstep; const char* b3 = b2 + kstep;
            if (last && has_next) S.a_ready(nxt);
            if constexpr (SP2) {
            PG8_LDB(B0, 0, 0); PG8_LDB(B1, 0, 1); PG8_SCHED; PG8_LDA(At, 0, 0); PG8_STAGE(PG8_SA(1, 1), a1 + hstep, voffA);
            PG8_WAIT_V(8); PG8_WAIT_L(0); PG8_BAR; PG8_MMA(0, 0, At, B0); PG8_MMA(0, 1, At, B1); PG8_BAR; PG8_SCHED;
            PG8_LDA(At, 0, 1); PG8_STAGE(PG8_SB(0, 0), b2, voffB); PG8_STAGE(PG8_SB(0, 1), b2 + hstep, voffB); PG8_STAGE(PG8_SA(0, 0), a2, voffA);
            PG8_WAIT_V(8); PG8_WAIT_L(0); PG8_BAR; PG8_MMA(1, 0, At, B0); PG8_MMA(1, 1, At, B1); PG8_BAR; PG8_SCHED;
            PG8_LDB(B0, 1, 0); PG8_LDB(B1, 1, 1); PG8_SCHED; PG8_LDA(At, 1, 0); PG8_STAGE(PG8_SA(0, 1), a2 + hstep, voffA);
            PG8_WAIT_V(8); PG8_WAIT_L(0); PG8_BAR; PG8_MMA(0, 0, At, B0); PG8_MMA(0, 1, At, B1); PG8_BAR; PG8_SCHED;
            PG8_LDA(At, 1, 1); PG8_STAGE(PG8_SB(1, 0), b3, voffB); PG8_STAGE(PG8_SB(1, 1), b3 + hstep, voffB); PG8_STAGE(PG8_SA(1, 0), a3, voffA);
            PG8_WAIT_V(8); PG8_WAIT_L(0); PG8_BAR; PG8_MMA(1, 0, At, B0); PG8_MMA(1, 1, At, B1); PG8_BAR; PG8_SCHED;
            } else {
            PG8_LDB(B0, 0, 0); PG8_SCHED; PG8_LDA(At, 0, 0); PG8_STAGE(PG8_SA(1, 1), a1 + hstep, voffA);
            PG8_WAIT_L(8); PG8_BAR; PG8_WAIT_L(0); PG8_MMA(0, 0, At, B0); PG8_BAR; PG8_SCHED;
            PG8_LDB(B1, 0, 1); PG8_STAGE(PG8_SB(0, 0), b2, voffB);
            PG8_BAR; PG8_WAIT_L(0); PG8_MMA(0, 1, At, B1); PG8_BAR;
            PG8_LDA(At, 0, 1); PG8_STAGE(PG8_SA(0, 0), a2, voffA);
            PG8_BAR; PG8_WAIT_L(0); PG8_MMA(1, 0, At, B0); PG8_BAR; PG8_SCHED;
            PG8_STAGE(PG8_SB(0, 1), b2 + hstep, voffB);
            PG8_WAIT_V(6); PG8_BAR; PG8_MMA(1, 1, At, B1); PG8_BAR;
            PG8_LDB(B0, 1, 0); PG8_SCHED; PG8_LDA(At, 1, 0); PG8_STAGE(PG8_SA(0, 1), a2 + hstep, voffA);
            PG8_WAIT_L(8); PG8_BAR; PG8_WAIT_L(0); PG8_MMA(0, 0, At, B0); PG8_BAR; PG8_SCHED;
            PG8_LDB(B1, 1, 1); PG8_STAGE(PG8_SB(1, 0), b3, voffB);
            PG8_BAR; PG8_WAIT_L(0); PG8_MMA(0, 1, At, B1); PG8_BAR;
            PG8_LDA(At, 1, 1); PG8_STAGE(PG8_SA(1, 0), a3, voffA);
            PG8_BAR; PG8_WAIT_L(0); PG8_MMA(1, 0, At, B0); PG8_BAR; PG8_SCHED;
            PG8_STAGE(PG8_SB(1, 1), b3 + hstep, voffB);
            PG8_WAIT_V(6); PG8_BAR; PG8_MMA(1, 1, At, B1); PG8_BAR;
            }
        }
        if constexpr (ALIGN_EPI) { if (wr == 0) PG8_BAR; }
        if constexpr (!Epi::AFTER_DRAIN) { E(acc, cur, wr, wc, fr, fq); S.done(cur); }
        if (!has_next) break;
#pragma unroll
        for (int a = 0; a < 2; ++a)
#pragma unroll
            for (int b = 0; b < 2; ++b)
#pragma unroll
                for (int m = 0; m < 4; ++m)
#pragma unroll
                    for (int n = 0; n < 2; ++n) acc[a][b][m][n] = (f32x4){0.f, 0.f, 0.f, 0.f};
        cur = nxt; cA = nA; cB = nB; ++ui;
        if constexpr (ALIGN_EPI) { if (wr == 1) PG8_BAR; }
    }
    PG8_WAIT_V(0);
    if constexpr (!ALIGN_EPI) { if (wr == 0) PG8_BAR; }
    PG8_BAR;
    if constexpr (Epi::AFTER_DRAIN) { E.fused(acc, cur, wr, wc, fr, fq, lds, wid, lane); S.done(cur); }
#undef PG8_SA
#undef PG8_SB
#undef PG8_STAGE
#undef PG8_LDA
#undef PG8_LDB
#undef PG8_MMA
#undef PG8_WAIT_V
#undef PG8_WAIT_L
#undef PG8_BAR
#undef PG8_SCHED
}
}
#define GAS __attribute__((address_space(1)))
#define LAS __attribute__((address_space(3)))
typedef unsigned short bf16;
typedef unsigned v4u __attribute__((ext_vector_type(4)));
typedef float f32x4 __attribute__((ext_vector_type(4)));
typedef short bf16x8 __attribute__((ext_vector_type(8)));
typedef GAS unsigned gu32;
typedef GAS unsigned long long gu64;
#define RLX_AGENT __ATOMIC_RELAXED, __HIP_MEMORY_SCOPE_AGENT
#define LDS_WAIT() asm volatile("s_waitcnt lgkmcnt(0)" ::: "memory")
#define VM_WAIT() asm volatile("s_waitcnt vmcnt(0)" ::: "memory")
__device__ __forceinline__ unsigned long long rt() { return __builtin_amdgcn_s_memrealtime(); }
__device__ __forceinline__ unsigned f2bf(float f) { unsigned u = __builtin_bit_cast(unsigned, f); return (u + 0x7fffu + ((u >> 16) & 1u)) >> 16; }
__device__ __forceinline__ unsigned pk2(float lo, float hi) { return f2bf(lo) | (f2bf(hi) << 16); }

#define XB_TMO      128
#define XB_XCNT(j)  (256  + 64 * (j))
#define XB_XSUB(j)  (1280 + 64 * (j))
#define XB_XGEN(j)  (2304 + 64 * (j))
#define XB_TOP      3328
#define XB_TOPGEN   3392
#define XCD_BAR_WORDS 3456
#define XB_SPIN_CAP (1u << 18)

__device__ __forceinline__ unsigned xb_ld(unsigned* p)              { return __hip_atomic_load(p, __ATOMIC_RELAXED, __HIP_MEMORY_SCOPE_AGENT); }
__device__ __forceinline__ unsigned xb_add(unsigned* p, unsigned v) { return __hip_atomic_fetch_add(p, v, __ATOMIC_RELAXED, __HIP_MEMORY_SCOPE_AGENT); }
__device__ __forceinline__ unsigned xb_xcc_id() { return (unsigned)__builtin_amdgcn_s_getreg((3 << 11) | 20) & 0xFu; }
#define XB_SPIN(cond, bar) do { unsigned _sp = 0; while (cond) { __builtin_amdgcn_s_sleep(1); \
    if ((++_sp & 255u) == 0u) { if (xb_ld(&(bar)[XB_TMO])) break; if (_sp > XB_SPIN_CAP) { atomicAdd(&(bar)[XB_TMO], 1u); break; } } } } while (0)

struct XcdBarrier {
    unsigned* bar; unsigned x;
    volatile LAS unsigned* st;
};

__device__ __forceinline__ XcdBarrier xcd_barrier_post(unsigned* bar, volatile LAS unsigned* st) {
    XcdBarrier b; b.bar = bar; b.x = xb_xcc_id(); b.st = st;
    if (threadIdx.x == 0) (void)xb_add(&bar[XB_XCNT(b.x)], 1u);
    return b;
}
__device__ __forceinline__ void xcd_barrier_complete(unsigned* bar, unsigned x, unsigned& nloc, unsigned& nx) {
    const unsigned G = gridDim.x * gridDim.y * gridDim.z;
    unsigned sum, cnt, mine, sp = 0u;
    for (;;) {
        sum = 0u; cnt = 0u; mine = 0u;
#pragma unroll
        for (unsigned j = 0; j < 16; ++j) { const unsigned c = xb_ld(&bar[XB_XCNT(j)]); sum += c; cnt += (c > 0u) ? 1u : 0u; mine = (j == x) ? c : mine; }
        if (sum == G) break;
        __builtin_amdgcn_s_sleep(1);
        if ((++sp & 255u) == 0u) { if (xb_ld(&bar[XB_TMO])) break; if (sp > XB_SPIN_CAP) { atomicAdd(&bar[XB_TMO], 1u); break; } }
    }
    nloc = mine > 0u ? mine : 1u; nx = cnt > 0u ? cnt : 1u;
}

__device__ __forceinline__ void xcd_barrier(const XcdBarrier& b) {
    asm volatile("s_waitcnt vmcnt(0)" ::: "memory");
    __syncthreads();
    if (threadIdx.x == 0) {
        unsigned* bar = b.bar;
        __builtin_amdgcn_s_waitcnt(0);
        unsigned nloc = b.st[0], nx = b.st[1];
        if (nloc == 0u) { xcd_barrier_complete(bar, b.x, nloc, nx); b.st[0] = nloc; b.st[1] = nx; }
        const unsigned old = xb_add(&bar[XB_XSUB(b.x)], 1u);
        const unsigned gen = old / nloc;
        if (old + 1u == (gen + 1u) * nloc) {
            __builtin_amdgcn_fence(__ATOMIC_RELEASE, "agent");
            asm volatile("s_waitcnt vmcnt(0)" ::: "memory");
            const unsigned og = xb_add(&bar[XB_TOP], 1u);
            const unsigned tg = og / nx;
            if (og + 1u == (tg + 1u) * nx) xb_add(&bar[XB_TOPGEN], 1u);
            else XB_SPIN(xb_ld(&bar[XB_TOPGEN]) == tg, bar);
            __builtin_amdgcn_fence(__ATOMIC_ACQUIRE, "agent");
            xb_add(&bar[XB_XGEN(b.x)], 1u);
            asm volatile("s_waitcnt vmcnt(0)" ::: "memory");
        } else {
            XB_SPIN(xb_ld(&bar[XB_XGEN(b.x)]) == gen, bar);
            __builtin_amdgcn_fence(__ATOMIC_ACQUIRE, "agent");
            asm volatile("s_waitcnt vmcnt(0)" ::: "memory");
        }
    }
    __syncthreads();
}

constexpr int NTOK = 16384, SEQ = 4096, NBATCH = 4, DM = 1024, NWAVES = 8, NTHREADS = 512;
constexpr int NIN = 8112, NIN_PAD = 8192;
constexpr int FFD = 2816, FFE = 3584, NEXP = 8;
constexpr int MOE_ROWS_MAX = 2 * NTOK + NEXP * 256;
constexpr float RMS_EPS = 1e-6f, LN_EPS_C = 1e-5f;
constexpr float QSCALE = 0.10206207261596577f * 1.4426950408889634f;

constexpr size_t MiB = 1u << 20;
constexpr size_t WS_CTL = 0, CTL_ZERO_BYTES = 1 * MiB;
constexpr size_t WS_WL0 = 1 * MiB, WS_WL_STRIDE = 26 * MiB;
constexpr size_t WO_WIN = 0, WO_WUQ = 16 * MiB, WO_WUKV = 16 * MiB + 768 * 1024, WO_WBR = 17 * MiB + 256 * 1024, WO_WOUT = 23 * MiB + 256 * 1024;
constexpr size_t WS_WGU = 53 * MiB, WS_WDN = 64 * MiB, WS_ROPE = 69 * MiB + 512 * 1024;
constexpr size_t WS_H = 70 * MiB;
constexpr size_t WS_Z = 108 * MiB, WS_XBC = 140 * MiB, WS_MISC = 188 * MiB, WS_U = 204 * MiB, WS_V = 236 * MiB, WS_QRAW = 268 * MiB, WS_KVRAW = 316 * MiB,
                 WS_K = 380 * MiB, WS_VM = 428 * MiB, WS_STATES = 460 * MiB, WS_QLAT = 492 * MiB, WS_AQ = 500 * MiB, WS_AKV = 508 * MiB;
constexpr size_t WS_MERGED = WS_Z, WS_YSSD = WS_V, WS_O = WS_KVRAW, WS_GATES = WS_K;
constexpr size_t WS_TBL = 512 * MiB;
constexpr size_t WS_VSTAT = WS_TBL, WS_DTG = WS_TBL + 1 * MiB, WS_CSG = WS_TBL + 2 * MiB, WS_CDEC = WS_TBL + 3 * MiB, WS_RSTD = WS_TBL + 3 * MiB + 256 * 1024,
                 WS_TOKE = WS_TBL + 3 * MiB + 512 * 1024, WS_TOKP = WS_TBL + 3 * MiB + 768 * 1024, WS_TOKR = WS_TBL + 4 * MiB, WS_TOKW = WS_TBL + 4 * MiB + 256 * 1024;
constexpr size_t WS_HID = 108 * MiB;
constexpr size_t WS_WMGU = 1 * MiB, WS_WMDN = 113 * MiB, WS_AG = 169 * MiB, WS_YP = WS_AG, WS_HIDM = 237 * MiB;
constexpr size_t WS_END = 518 * MiB;
static_assert(WS_HIDM + (size_t)MOE_ROWS_MAX * FFE * 2 <= WS_TBL && WS_AG + (size_t)MOE_ROWS_MAX * DM * 2 <= WS_HIDM, "MoE overlay");
static_assert(WS_WL0 + 2 * WS_WL_STRIDE <= WS_WGU && WS_WDN + (size_t)DM * FFD * 2 <= WS_ROPE && WS_ROPE + 4096 * 16 * 8 <= WS_H, "weight map");
static_assert(WS_GATES + (size_t)NTOK * 3072 * 2 <= WS_QLAT && WS_AKV + (size_t)NTOK * 128 * 2 <= WS_TBL, "mixer map");
constexpr int CW_TMO = 0, CW_BAR = 4096, CW_CNT = 16384;

constexpr int LDS_BYTES = 147456;
constexpr int LDS_MISC_OFF = 131072 + 8192;

typedef unsigned u32x2 __attribute__((ext_vector_type(2)));
typedef float f32x16 __attribute__((ext_vector_type(16)));
typedef short s16x4 __attribute__((ext_vector_type(4)));
using pg8::pkbf; using pg8::bflo; using pg8::bfhi; using pg8::fsigmoid; using pg8::bf16_t; using pg8::u32x4;

struct Ctx {
    LAS unsigned char* lds; int tid, lane, wave, vcu, G, bx;
};
__device__ __forceinline__ float lane_xor(float v, int o, int lane) { return __int_as_float(__builtin_amdgcn_ds_bpermute((lane ^ o) << 2, __float_as_int(v))); }
__device__ __forceinline__ float lane_up(float v, int o, int lane) { return __int_as_float(__builtin_amdgcn_ds_bpermute((lane - o) << 2, __float_as_int(v))); }
__device__ __forceinline__ float wave_sum(float v, int lane) {
#pragma unroll
    for (int o = 1; o < 64; o <<= 1) v += lane_xor(v, o, lane);
    return v;
}
__device__ __forceinline__ int crow(int r, int hi) { return (r & 3) + 8 * (r >> 2) + 4 * hi; }
__device__ __forceinline__ s16x4 tr16(LAS const unsigned char* p) { typedef short v4i16_t __attribute__((ext_vector_type(4))); return __builtin_bit_cast(s16x4, __builtin_amdgcn_ds_read_tr16_b64_v4i16((LAS v4i16_t*)p)); }
__device__ __forceinline__ bf16x8 tr_frag(LAS const unsigned char* tile, int pitch, int kb, int c0, int lane) {
    const int g = lane >> 4, hi = g >> 1, q = (lane & 15) >> 2, p = lane & 3;
    LAS const unsigned char* a = tile + (kb + 8 * hi + q) * pitch + (c0 + 16 * (g & 1) + 4 * p) * 2;
    const s16x4 lo = tr16(a), h4 = tr16(a + 4 * pitch);
    return (bf16x8){lo[0], lo[1], lo[2], lo[3], h4[0], h4[1], h4[2], h4[3]};
}
__device__ __forceinline__ bf16x8 tr_frag_acc(LAS const unsigned char* tile, int pitch, int kb, int c0, int lane) {
    const int g = lane >> 4, hi = g >> 1, q = (lane & 15) >> 2, p = lane & 3;
    LAS const unsigned char* a = tile + (kb + 4 * hi + q) * pitch + (c0 + 16 * (g & 1) + 4 * p) * 2;
    const s16x4 lo = tr16(a), h4 = tr16(a + 8 * pitch);
    return (bf16x8){lo[0], lo[1], lo[2], lo[3], h4[0], h4[1], h4[2], h4[3]};
}
__device__ __forceinline__ bf16x8 row_frag(LAS const unsigned char* tile, int pitch, int r0, int kb, int lane) {
    return *(LAS const bf16x8*)(tile + (r0 + (lane & 31)) * pitch + (kb + 8 * (lane >> 5)) * 2);
}
#define MFMA32(a, b, c) __builtin_amdgcn_mfma_f32_32x32x16_bf16((a), (b), (c), 0, 0, 0)
__device__ __forceinline__ f32x16 zero16() { f32x16 z;
#pragma unroll
    for (int i = 0; i < 16; ++i) z[i] = 0.f;
    return z; }
__device__ __forceinline__ void unpack8(const u32x4 w, float (&f)[8]) { f[0] = bflo(w.x); f[1] = bfhi(w.x); f[2] = bflo(w.y); f[3] = bfhi(w.y); f[4] = bflo(w.z); f[5] = bfhi(w.z); f[6] = bflo(w.w); f[7] = bfhi(w.w); }
__device__ __forceinline__ u32x4 pack8(const float (&f)[8]) { u32x4 w; w.x = pkbf(f[0], f[1]); w.y = pkbf(f[2], f[3]); w.z = pkbf(f[4], f[5]); w.w = pkbf(f[6], f[7]); return w; }
__device__ __forceinline__ float silu_f(float x) { return x * fsigmoid(x); }

template <int KIND> __device__ __forceinline__ int wmap(int n) {
    if (KIND == 1) {
        if (n < 2560) return n;
        if (n < 2576) return 2720 + (n - 2560);
        if (n < 3600) return 3072 + (n - 2576);
        if (n < 4624) return 4096 + (n - 3600);
        if (n < 4880) return 2816 + (n - 4624);
        if (n < 5008) return 2560 + (n - 4880);
        if (n < 5040) return 2688 + (n - 5008);
        return 5120 + (n - 5040);
    }
    if (KIND == 2) return (n >> 7) * 256 + (n & 127);
    if (KIND == 3) return (n >> 7) * 256 + 128 + (n & 127);
    return n;
}
template <int KIND> __device__ __forceinline__ void transpose_item(const float* W, int K, int N, bf16_t* WT, LAS float* scr, int item, int lane) {
    const int nblk = (N + 31) / 32, kb = item / nblk, nb = item % nblk, k0 = 64 * kb, n0 = 32 * nb;
    const bool ok = (n0 + (lane & 31)) < N;
#pragma unroll 8
    for (int i = 0; i < 32; ++i) { const int kk = 2 * i + (lane >> 5); scr[kk * 33 + (lane & 31)] = ok ? W[(size_t)(k0 + kk) * N + n0 + (lane & 31)] : 0.f; }
    LDS_WAIT(); asm volatile("" ::: "memory");
    const int c = lane & 7;
#pragma unroll
    for (int j = 0; j < 4; ++j) { const int n = (lane >> 3) + 8 * j; const LAS float* s = scr + (8 * c) * 33 + n;
        u32x4 o; o.x = pkbf(s[0 * 33], s[1 * 33]); o.y = pkbf(s[2 * 33], s[3 * 33]); o.z = pkbf(s[4 * 33], s[5 * 33]); o.w = pkbf(s[6 * 33], s[7 * 33]);
        if (n0 + n < N) *(u32x4*)(WT + (size_t)wmap<KIND>(n0 + n) * K + k0 + 8 * c) = o; }
    LDS_WAIT(); asm volatile("" ::: "memory");
}
template <int KIND> __device__ __forceinline__ void convert_matrix(const Ctx& F, const float* W, int K, int N, bf16_t* WT) {
    LAS float* scr = (LAS float*)(F.lds + F.wave * 8704);
    const int gw = F.vcu * NWAVES + F.wave, NGW = F.G * NWAVES, nitems = (K / 64) * ((N + 31) / 32);
    for (int it = gw; it < nitems; it += NGW) transpose_item<KIND>(W, K, N, WT, scr, it, F.lane);
}

__device__ __forceinline__ void rmsnorm_rows(const Ctx& F, const float* x, const float* g, bf16_t* H) {
    const int gw = F.vcu * NWAVES + F.wave, NGW = F.G * NWAVES;
    f32x4 gv[4];
#pragma unroll
    for (int j = 0; j < 4; ++j) gv[j] = ((const f32x4*)g)[F.lane + 64 * j];
    for (int m = gw; m < NTOK; m += NGW) {
        const f32x4* xr = (const f32x4*)(x + (size_t)m * DM) + F.lane;
        f32x4 v[4]; float s = 0.f;
#pragma unroll
        for (int j = 0; j < 4; ++j) { v[j] = xr[64 * j]; s += (v[j].x * v[j].x + v[j].y * v[j].y) + (v[j].z * v[j].z + v[j].w * v[j].w); }
        const float rstd = 1.0f / sqrtf(wave_sum(s, F.lane) * (1.0f / DM) + RMS_EPS);
        u32x2* o = (u32x2*)(H + (size_t)m * DM) + F.lane;
#pragma unroll
        for (int j = 0; j < 4; ++j) { u32x2 w; w.x = pkbf(v[j].x * rstd * gv[j].x, v[j].y * rstd * gv[j].y); w.y = pkbf(v[j].z * rstd * gv[j].z, v[j].w * rstd * gv[j].w); o[64 * j] = w; }
    }
}
__device__ __forceinline__ void mixer_rowpass(const Ctx& F, const bf16_t* QLAT, const float* MISC, const bf16_t* V, const float* qg, const float* kvg, bf16_t* AQ, bf16_t* AKV, float* VSTAT) {
    const int gw = F.vcu * NWAVES + F.wave, NGW = F.G * NWAVES, lane = F.lane;
    const f32x4 gq = ((const f32x4*)qg)[lane]; const float gk0 = kvg[2 * lane], gk1 = kvg[2 * lane + 1];
    for (int m = gw; m < NTOK; m += NGW) {
        { const u32x2 w = ((const u32x2*)(QLAT + (size_t)m * 256))[lane]; const float a = bflo(w.x), b = bfhi(w.x), c = bflo(w.y), d = bfhi(w.y);
          const float rs = 1.0f / sqrtf(wave_sum((a * a + b * b) + (c * c + d * d), lane) * (1.0f / 256.0f) + RMS_EPS);
          u32x2 o; o.x = pkbf(a * rs * gq.x, b * rs * gq.y); o.y = pkbf(c * rs * gq.z, d * rs * gq.w); ((u32x2*)(AQ + (size_t)m * 256))[lane] = o; }
        { const float a = MISC[(size_t)m * 256 + 2 * lane], b = MISC[(size_t)m * 256 + 2 * lane + 1];
          const float rs = 1.0f / sqrtf(wave_sum(a * a + b * b, lane) * (1.0f / 128.0f) + RMS_EPS);
          ((unsigned*)(AKV + (size_t)m * 128))[lane] = pkbf(a * rs * gk0, b * rs * gk1); }
        { const u32x4 w0 = ((const u32x4*)(V + (size_t)m * 1024))[lane], w1 = ((const u32x4*)(V + (size_t)m * 1024))[64 + lane]; float f[16];
          { float t[8]; unpack8(w0, t);
#pragma unroll
            for (int i = 0; i < 8; ++i) f[i] = t[i]; unpack8(w1, t);
#pragma unroll
            for (int i = 0; i < 8; ++i) f[8 + i] = t[i]; }
          float s = 0.f;
#pragma unroll
          for (int i = 0; i < 16; ++i) s += f[i];
          const float mean = wave_sum(s, lane) * (1.0f / 1024.0f); float q = 0.f;
#pragma unroll
          for (int i = 0; i < 16; ++i) { const float d = f[i] - mean; q += d * d; }
          const float rstd = 1.0f / sqrtf(wave_sum(q, lane) * (1.0f / 1024.0f) + LN_EPS_C);
          if (lane == 0) { VSTAT[2 * m] = mean; VSTAT[2 * m + 1] = rstd; } }
    }
}
__device__ __forceinline__ void qk_finalize(const Ctx& F, bf16_t* QRAW, const bf16_t* KVRAW, const float* MISC, const float* qhg, const float* khg, const float* ROPE, bf16_t* Kout, bf16_t* Vout) {
    const int gw = F.vcu * NWAVES + F.wave, NGW = F.G * NWAVES, lane = F.lane, h = lane >> 2, j = lane & 3;
    float gqn[16], gkn[16], gq1[4], gq2[4], gk1[4], gk2[4];
#pragma unroll
    for (int i = 0; i < 16; ++i) { gqn[i] = qhg[16 * j + i]; gkn[i] = khg[16 * j + i]; }
#pragma unroll
    for (int i = 0; i < 4; ++i) { gq1[i] = qhg[64 + 4 * j + i]; gq2[i] = qhg[80 + 4 * j + i]; gk1[i] = khg[64 + 4 * j + i]; gk2[i] = khg[80 + 4 * j + i]; }
    for (int m = gw; m < NTOK; m += NGW) {
        const int pos = m & (SEQ - 1);
        const f32x4 cs0 = *(const f32x4*)(ROPE + (size_t)pos * 32 + 8 * j), cs1 = *(const f32x4*)(ROPE + (size_t)pos * 32 + 8 * j + 4);
        const float cc[4] = {cs0.x, cs0.z, cs1.x, cs1.z}, ss[4] = {cs0.y, cs0.w, cs1.y, cs1.w};
        {
            bf16_t* qb = QRAW + (size_t)m * 1536 + h * 96;
            float n[16], x1[4], x2[4]; { float t[8]; unpack8(*(const u32x4*)(qb + 16 * j), t);
#pragma unroll
                for (int i = 0; i < 8; ++i) n[i] = t[i]; unpack8(*(const u32x4*)(qb + 16 * j + 8), t);
#pragma unroll
                for (int i = 0; i < 8; ++i) n[8 + i] = t[i]; }
            { const u32x2 a = *(const u32x2*)(qb + 64 + 4 * j), b = *(const u32x2*)(qb + 80 + 4 * j); x1[0] = bflo(a.x); x1[1] = bfhi(a.x); x1[2] = bflo(a.y); x1[3] = bfhi(a.y); x2[0] = bflo(b.x); x2[1] = bfhi(b.x); x2[2] = bflo(b.y); x2[3] = bfhi(b.y); }
            float s = 0.f;
#pragma unroll
            for (int i = 0; i < 16; ++i) s += n[i] * n[i];
#pragma unroll
            for (int i = 0; i < 4; ++i) s += x1[i] * x1[i] + x2[i] * x2[i];
            s += lane_xor(s, 1, lane); s += lane_xor(s, 2, lane);
            const float rs = QSCALE / sqrtf(s * (1.0f / 96.0f) + RMS_EPS);
#pragma unroll
            for (int i = 0; i < 16; ++i) n[i] *= rs * gqn[i];
            float o1[4], o2[4];
#pragma unroll
            for (int i = 0; i < 4; ++i) { const float a = x1[i] * rs * gq1[i], b = x2[i] * rs * gq2[i]; o1[i] = a * cc[i] - b * ss[i]; o2[i] = a * ss[i] + b * cc[i]; }
            { float t[8];
#pragma unroll
              for (int i = 0; i < 8; ++i) t[i] = n[i]; *(u32x4*)(qb + 16 * j) = pack8(t);
#pragma unroll
              for (int i = 0; i < 8; ++i) t[i] = n[8 + i]; *(u32x4*)(qb + 16 * j + 8) = pack8(t); }
            { u32x2 a, b; a.x = pkbf(o1[0], o1[1]); a.y = pkbf(o1[2], o1[3]); b.x = pkbf(o2[0], o2[1]); b.y = pkbf(o2[2], o2[3]); *(u32x2*)(qb + 64 + 4 * j) = a; *(u32x2*)(qb + 80 + 4 * j) = b; }
        }
        {
            const bf16_t* kvb = KVRAW + (size_t)m * 2048 + h * 128;
            float n[16], x1[4], x2[4]; { float t[8]; unpack8(*(const u32x4*)(kvb + 16 * j), t);
#pragma unroll
                for (int i = 0; i < 8; ++i) n[i] = t[i]; unpack8(*(const u32x4*)(kvb + 16 * j + 8), t);
#pragma unroll
                for (int i = 0; i < 8; ++i) n[8 + i] = t[i]; }
            { const f32x4 a = *(const f32x4*)(MISC + (size_t)m * 256 + 128 + 4 * j), b = *(const f32x4*)(MISC + (size_t)m * 256 + 144 + 4 * j);
              x1[0] = a.x; x1[1] = a.y; x1[2] = a.z; x1[3] = a.w; x2[0] = b.x; x2[1] = b.y; x2[2] = b.z; x2[3] = b.w; }
            float s = 0.f;
#pragma unroll
            for (int i = 0; i < 16; ++i) s += n[i] * n[i];
#pragma unroll
            for (int i = 0; i < 4; ++i) s += x1[i] * x1[i] + x2[i] * x2[i];
            s += lane_xor(s, 1, lane); s += lane_xor(s, 2, lane);
            const float rs = 1.0f / sqrtf(s * (1.0f / 96.0f) + RMS_EPS);
#pragma unroll
            for (int i = 0; i < 16; ++i) n[i] *= rs * gkn[i];
            float o1[4], o2[4];
#pragma unroll
            for (int i = 0; i < 4; ++i) { const float a = x1[i] * rs * gk1[i], b = x2[i] * rs * gk2[i]; o1[i] = a * cc[i] - b * ss[i]; o2[i] = a * ss[i] + b * cc[i]; }
            bf16_t* kb = Kout + (size_t)m * 1536 + h * 96;
            { float t[8];
#pragma unroll
              for (int i = 0; i < 8; ++i) t[i] = n[i]; *(u32x4*)(kb + 16 * j) = pack8(t);
#pragma unroll
              for (int i = 0; i < 8; ++i) t[i] = n[8 + i]; *(u32x4*)(kb + 16 * j + 8) = pack8(t); }
            { u32x2 a, b; a.x = pkbf(o1[0], o1[1]); a.y = pkbf(o1[2], o1[3]); b.x = pkbf(o2[0], o2[1]); b.y = pkbf(o2[2], o2[3]); *(u32x2*)(kb + 64 + 4 * j) = a; *(u32x2*)(kb + 80 + 4 * j) = b; }
            bf16_t* vb = Vout + (size_t)m * 1024 + h * 64 + 16 * j;
            *(u32x4*)vb = *(const u32x4*)(kvb + 64 + 16 * j); *(u32x4*)(vb + 8) = *(const u32x4*)(kvb + 64 + 16 * j + 8);
        }
    }
}

template <int R> __device__ __forceinline__ void conv8(const bf16_t* xb, int s0, int ch0, const float* cw, const float* cb, float (&out)[R][8]) {
    float w[4][8], bias[8];
#pragma unroll
    for (int j = 0; j < 4; ++j) { const f32x4 a = *(const f32x4*)(cw + j * 1536 + ch0), b = *(const f32x4*)(cw + j * 1536 + ch0 + 4); w[j][0] = a.x; w[j][1] = a.y; w[j][2] = a.z; w[j][3] = a.w; w[j][4] = b.x; w[j][5] = b.y; w[j][6] = b.z; w[j][7] = b.w; }
    { const f32x4 a = *(const f32x4*)(cb + ch0), b = *(const f32x4*)(cb + ch0 + 4); bias[0] = a.x; bias[1] = a.y; bias[2] = a.z; bias[3] = a.w; bias[4] = b.x; bias[5] = b.y; bias[6] = b.z; bias[7] = b.w; }
    float x[R + 3][8];
#pragma unroll
    for (int i = 0; i < R + 3; ++i) { const int s = s0 - 3 + i; u32x4 raw = (u32x4){0u, 0u, 0u, 0u}; if (s >= 0) raw = *(const u32x4*)(xb + (size_t)s * 1536 + ch0); unpack8(raw, x[i]); }
#pragma unroll
    for (int r = 0; r < R; ++r)
#pragma unroll
        for (int e = 0; e < 8; ++e) { float a = bias[e];
#pragma unroll
            for (int j = 0; j < 4; ++j) a += w[j][e] * x[r + j][e];
            out[r][e] = silu_f(a); }
}
constexpr int SA_BS = 0, SA_XW = 40960, SA_CS = 65536, SA_DT = 69632;
constexpr int SC_CS_T = 0, SC_BM = 34816, SC_XS = 69632, SC_PV = 94208, SC_CS = 111616, SC_DT = 115712, SC_SSQ = 119808;
__device__ __forceinline__ void ssd_pass_a(const Ctx& F, const bf16_t* XBC, const float* MISC, const float* conv_w, const float* conv_b, const float* dt_bias, const float* a_log,
                                           bf16_t* STATES, float* CSG, float* DTG, float* CDEC) {
    const int tid = F.tid, lane = F.lane, w = F.wave, r32 = lane & 31, hi = lane >> 5;
    LAS unsigned char* Bs = F.lds + SA_BS; LAS unsigned char* Xw = F.lds + SA_XW; LAS float* csl = (LAS float*)(F.lds + SA_CS); LAS float* dtl = (LAS float*)(F.lds + SA_DT);
#pragma unroll 1
    for (int item = F.vcu; item < NBATCH * 32 * 2; item += F.G) {
        const int b = item >> 6, c = (item >> 1) & 31, g = item & 1;
        const bf16_t* xb = XBC + (size_t)b * SEQ * 1536; const int s_base = c * 128; const size_t tok0 = (size_t)b * SEQ + s_base;
        {
            const int cc = tid & 15, pr = tid >> 4; float o[4][8]; conv8<4>(xb, s_base + 4 * pr, 1024 + g * 128 + 8 * cc, conv_w, conv_b, o);
#pragma unroll
            for (int r = 0; r < 4; ++r) *(LAS u32x4*)(Bs + (4 * pr + r) * 320 + cc * 16) = pack8(o[r]);
        }
        {
            const int h = 8 * g + w; const float a = -__expf(a_log[h]), bias = dt_bias[h];
            float d0 = MISC[(tok0 + 2 * lane) * 256 + 160 + h] + bias, d1 = MISC[(tok0 + 2 * lane + 1) * 256 + 160 + h] + bias;
            d0 = d0 > 20.f ? d0 : __logf(1.0f + __expf(d0)); d1 = d1 > 20.f ? d1 : __logf(1.0f + __expf(d1));
            const float v0 = d0 * a, v1 = d1 * a; float inc = v0 + v1;
#pragma unroll
            for (int o = 1; o < 64; o <<= 1) { const float t = lane_up(inc, o, lane); if (lane >= o) inc += t; }
            const float c1 = inc, c0 = inc - v1;
            csl[w * 128 + 2 * lane] = c0; csl[w * 128 + 2 * lane + 1] = c1; dtl[w * 128 + 2 * lane] = d0; dtl[w * 128 + 2 * lane + 1] = d1;
            CSG[(tok0 + 2 * lane) * 16 + h] = c0; CSG[(tok0 + 2 * lane + 1) * 16 + h] = c1; DTG[(tok0 + 2 * lane) * 16 + h] = d0; DTG[(tok0 + 2 * lane + 1) * 16 + h] = d1;
            if (lane == 63) CDEC[(b * 32 + c) * 16 + h] = __expf(c1);
        }
        __syncthreads();
#pragma unroll 1
        for (int hh = 0; hh < 8; ++hh) {
            const int h = 8 * g + hh;
            {
                const int cc = tid & 7, pr = tid >> 3; float o[2][8]; conv8<2>(xb, s_base + 2 * pr, 64 * h + 8 * cc, conv_w, conv_b, o);
                const float ce = csl[hh * 128 + 127];
#pragma unroll
                for (int r = 0; r < 2; ++r) { const int l = 2 * pr + r; const float sc = dtl[hh * 128 + l] * __expf(ce - csl[hh * 128 + l]);
#pragma unroll
                    for (int e = 0; e < 8; ++e) o[r][e] *= sc;
                    *(LAS u32x4*)(Xw + l * 192 + cc * 16) = pack8(o[r]); }
            }
            __syncthreads();
            {   const int tp = w >> 2, tn = w & 3; f32x16 acc = zero16();
#pragma unroll
                for (int ks = 0; ks < 8; ++ks) acc = MFMA32(tr_frag(Xw, 192, 16 * ks, 32 * tp, lane), tr_frag(Bs, 320, 16 * ks, 32 * tn, lane), acc);
                bf16_t* st = STATES + ((size_t)((b * 32 + c) * 16 + h) * 64) * 128;
#pragma unroll
                for (int r = 0; r < 16; ++r) st[(size_t)(32 * tp + crow(r, hi)) * 128 + 32 * tn + r32] = (bf16_t)(pkbf(acc[r], 0.f) & 0xffffu);
            }
            __syncthreads();
        }
    }
}
__device__ __forceinline__ void ssd_scan(const Ctx& F, bf16_t* STATES, const float* CDEC) {
    const int gt = F.vcu * NTHREADS + F.tid, NGT = F.G * NTHREADS;
    for (int v = gt; v < NBATCH * 16 * 64 * 16; v += NGT) {
        const int bh = v >> 10, b = bh >> 4, h = bh & 15, rem = v & 1023;
        float carry[8];
#pragma unroll
        for (int i = 0; i < 8; ++i) carry[i] = 0.f;
        for (int c = 0; c < 32; ++c) {
            u32x4* p = (u32x4*)(STATES + ((size_t)((b * 32 + c) * 16 + h) * 64) * 128 + (size_t)rem * 8);
            float s[8]; unpack8(*p, s); const float dec = CDEC[(b * 32 + c) * 16 + h];
            *p = pack8(carry);
#pragma unroll
            for (int i = 0; i < 8; ++i) carry[i] = carry[i] * dec + s[i];
        }
    }
}
__device__ __forceinline__ void ssd_pass_c(const Ctx& F, const bf16_t* XBC, const bf16_t* STATES, const float* CSG, const float* DTG, const bf16_t* Z, const float* conv_w, const float* conv_b,
                                           const float* d_skip, const float* norm_g, bf16_t* YSSD) {
    const int tid = F.tid, lane = F.lane, w = F.wave, r32 = lane & 31, hi = lane >> 5;
    LAS unsigned char* Cs = F.lds + SC_CS_T; LAS unsigned char* Bm = F.lds + SC_BM; LAS unsigned char* Xs = F.lds + SC_XS; LAS unsigned char* PVs = F.lds + SC_PV;
    LAS float* csl = (LAS float*)(F.lds + SC_CS); LAS float* dtl = (LAS float*)(F.lds + SC_DT); LAS float* ssql = (LAS float*)(F.lds + SC_SSQ);
#pragma unroll 1
    for (int item = F.vcu; item < NBATCH * 32 * 2; item += F.G) {
        const int b = item >> 6, c = (item >> 1) & 31, g = item & 1;
        const bf16_t* xb = XBC + (size_t)b * SEQ * 1536; const int s_base = c * 128; const size_t tok0 = (size_t)b * SEQ + s_base;
        {   const int cc = tid & 15, pr = tid >> 4; float o[4][8];
            conv8<4>(xb, s_base + 4 * pr, 1280 + g * 128 + 8 * cc, conv_w, conv_b, o);
#pragma unroll
            for (int r = 0; r < 4; ++r) *(LAS u32x4*)(Cs + (4 * pr + r) * 272 + cc * 16) = pack8(o[r]);
            conv8<4>(xb, s_base + 4 * pr, 1024 + g * 128 + 8 * cc, conv_w, conv_b, o);
#pragma unroll
            for (int r = 0; r < 4; ++r) *(LAS u32x4*)(Bm + (4 * pr + r) * 272 + cc * 16) = pack8(o[r]);
        }
#pragma unroll
        for (int i = 0; i < 2; ++i) { const int id = tid + 512 * i, l = id >> 3, hh = id & 7; csl[hh * 128 + l] = CSG[(tok0 + l) * 16 + 8 * g + hh]; dtl[hh * 128 + l] = DTG[(tok0 + l) * 16 + 8 * g + hh]; }
        __syncthreads();
        const int tr = w >> 1, tc0 = 2 * (w & 1);
        f32x16 cb[2]; cb[0] = zero16(); cb[1] = zero16();
#pragma unroll
        for (int ks = 0; ks < 8; ++ks) { const bf16x8 a = row_frag(Cs, 272, 32 * tr, 16 * ks, lane);
            cb[0] = MFMA32(a, row_frag(Bm, 272, 32 * tc0, 16 * ks, lane), cb[0]); cb[1] = MFMA32(a, row_frag(Bm, 272, 32 * tc0 + 32, 16 * ks, lane), cb[1]); }
        __syncthreads();
        float ssq[16];
#pragma unroll
        for (int r = 0; r < 16; ++r) ssq[r] = 0.f;
        const int tp = w & 1;
#pragma unroll 1
        for (int hh = 0; hh < 8; ++hh) {
            const int h = 8 * g + hh;
            {   const int cc = tid & 7, pr = tid >> 3; float o[2][8]; conv8<2>(xb, s_base + 2 * pr, 64 * h + 8 * cc, conv_w, conv_b, o);
#pragma unroll
                for (int r = 0; r < 2; ++r) *(LAS u32x4*)(Xs + (2 * pr + r) * 192 + cc * 16) = pack8(o[r]);
                const bf16_t* st = STATES + ((size_t)((b * 32 + c) * 16 + h) * 64) * 128;
#pragma unroll
                for (int i = 0; i < 2; ++i) { const int id = tid + 512 * i, p = id >> 4, part = id & 15; *(LAS u32x4*)(PVs + p * 272 + part * 16) = *(const u32x4*)(st + (size_t)p * 128 + part * 8); }
            }
#pragma unroll
            for (int j = 0; j < 2; ++j) { const int s = 32 * (tc0 + j) + r32; const float css = csl[hh * 128 + s], dts = dtl[hh * 128 + s];
#pragma unroll
                for (int r = 0; r < 16; ++r) { const int l = 32 * tr + crow(r, hi); const float v = (s <= l) ? cb[j][r] * __expf(csl[hh * 128 + l] - css) * dts : 0.f;
                    *(LAS bf16_t*)(Bm + l * 272 + s * 2) = (bf16_t)(pkbf(v, 0.f) & 0xffffu); } }
            __syncthreads();
            f32x16 a1 = zero16(), a2 = zero16();
#pragma unroll
            for (int ks = 0; ks < 8; ++ks) a1 = MFMA32(row_frag(Bm, 272, 32 * tr, 16 * ks, lane), tr_frag(Xs, 192, 16 * ks, 32 * tp, lane), a1);
#pragma unroll
            for (int ks = 0; ks < 8; ++ks) a2 = MFMA32(row_frag(Cs, 272, 32 * tr, 16 * ks, lane), row_frag(PVs, 272, 32 * tp, 16 * ks, lane), a2);
            const float dsk = d_skip[h]; const int p = 32 * tp + r32;
#pragma unroll
            for (int r = 0; r < 16; ++r) { const int l = 32 * tr + crow(r, hi);
                const float xv = __uint_as_float((unsigned)(*(LAS const bf16_t*)(Xs + l * 192 + p * 2)) << 16);
                const float y = a1[r] + __expf(csl[hh * 128 + l]) * a2[r] + dsk * xv;
                const size_t off = (tok0 + l) * 1024 + 64 * h + p;
                const float yg = y * __uint_as_float((unsigned)Z[off] << 16);
                ssq[r] += yg * yg; YSSD[off] = (bf16_t)(pkbf(yg, 0.f) & 0xffffu); }
            __syncthreads();
        }
#pragma unroll
        for (int r = 0; r < 16; ++r) { float s = ssq[r]; s += lane_xor(s, 1, lane); s += lane_xor(s, 2, lane); s += lane_xor(s, 4, lane); s += lane_xor(s, 8, lane); s += lane_xor(s, 16, lane); if (r32 == 0) ssql[tp * 128 + 32 * tr + crow(r, hi)] = s; }
        __syncthreads();
        float rs[16];
#pragma unroll
        for (int r = 0; r < 16; ++r) { const int l = 32 * tr + crow(r, hi); rs[r] = 1.0f / sqrtf((ssql[l] + ssql[128 + l]) * (1.0f / 512.0f) + RMS_EPS); }
#pragma unroll 1
        for (int hh = 0; hh < 8; ++hh) { const int h = 8 * g + hh, p = 32 * tp + r32; const float ng = norm_g[64 * h + p];
#pragma unroll
            for (int r = 0; r < 16; ++r) { const size_t off = (tok0 + 32 * tr + crow(r, hi)) * 1024 + 64 * h + p;
                YSSD[off] = (bf16_t)(pkbf(__uint_as_float((unsigned)YSSD[off] << 16) * rs[r] * ng, 0.f) & 0xffffu); } }
        __syncthreads();
    }
}

constexpr int SG_W = 0, SG_V = 34816;
__device__ __forceinline__ void sgu_phase(const Ctx& F, bf16_t* U, const bf16_t* V, const float* VSTAT, const float* ln_g, const float* ln_b, const float* sgu_w, const float* sgu_b) {
    const int tid = F.tid, lane = F.lane, w = F.wave, r32 = lane & 31, hi = lane >> 5;
    LAS unsigned char* Ws = F.lds + SG_W; LAS unsigned char* Vn = F.lds + SG_V;
    int gcur = -1;
#pragma unroll 1
    for (int k = 0; k < 4; ++k) {
        const int item = F.vcu * 4 + k; if (item >= 1024) break;
        const int g = item >> 7, bc = item & 127; const size_t tok0 = (size_t)bc * 128;
        if (g != gcur) { gcur = g;
            const int t = tid >> 2, part = tid & 3; const float* src = sgu_w + ((size_t)g * 128 + t) * 128 + 32 * part;
#pragma unroll
            for (int q = 0; q < 4; ++q) { const f32x4 a = *(const f32x4*)(src + 8 * q), bb = *(const f32x4*)(src + 8 * q + 4); float f[8] = {a.x, a.y, a.z, a.w, bb.x, bb.y, bb.z, bb.w};
#pragma unroll
                for (int e = 0; e < 8; ++e) if (32 * part + 8 * q + e > t) f[e] = 0.f;
                *(LAS u32x4*)(Ws + t * 272 + (32 * part + 8 * q) * 2) = pack8(f); }
        }
#pragma unroll
        for (int i = 0; i < 4; ++i) { const int id = tid + 512 * i, s = id >> 4, part = id & 15; const size_t tk = tok0 + s;
            float f[8]; unpack8(*(const u32x4*)(V + tk * 1024 + 128 * g + 8 * part), f); const float mean = VSTAT[2 * tk], rstd = VSTAT[2 * tk + 1];
            const f32x4 g0 = *(const f32x4*)(ln_g + 128 * g + 8 * part), g1 = *(const f32x4*)(ln_g + 128 * g + 8 * part + 4), b0 = *(const f32x4*)(ln_b + 128 * g + 8 * part), b1 = *(const f32x4*)(ln_b + 128 * g + 8 * part + 4);
            const float gg[8] = {g0.x, g0.y, g0.z, g0.w, g1.x, g1.y, g1.z, g1.w}, bb[8] = {b0.x, b0.y, b0.z, b0.w, b1.x, b1.y, b1.z, b1.w};
#pragma unroll
            for (int e = 0; e < 8; ++e) f[e] = (f[e] - mean) * rstd * gg[e] + bb[e];
            *(LAS u32x4*)(Vn + s * 320 + part * 16) = pack8(f); }
        __syncthreads();
        const int tr = w >> 1, tc0 = 2 * (w & 1);
        f32x16 acc[2]; acc[0] = zero16(); acc[1] = zero16();
#pragma unroll
        for (int ks = 0; ks < 8; ++ks) { const bf16x8 a = row_frag(Ws, 272, 32 * tr, 16 * ks, lane);
            acc[0] = MFMA32(a, tr_frag(Vn, 320, 16 * ks, 32 * tc0, lane), acc[0]); acc[1] = MFMA32(a, tr_frag(Vn, 320, 16 * ks, 32 * tc0 + 32, lane), acc[1]); }
#pragma unroll
        for (int j = 0; j < 2; ++j)
#pragma unroll
            for (int r = 0; r < 16; ++r) { const int t = 32 * tr + crow(r, hi); const size_t off = (tok0 + t) * 1024 + 128 * g + 32 * (tc0 + j) + r32;
                const float y = __uint_as_float((unsigned)U[off] << 16) * (acc[j][r] + sgu_b[g * 128 + t]); U[off] = (bf16_t)(pkbf(y, 0.f) & 0xffffu); }
        __syncthreads();
    }
}

constexpr int AT_K = 0, AT_KB = 13312, AT_V = 26624, AT_VB = 12288, AT_O = 51200;
__device__ __forceinline__ void attn_unit(const Ctx& F, int b, int h, int qb, const bf16_t* Q, const bf16_t* K, const bf16_t* V, bf16_t* O) {
    const int tid = F.tid, lane = F.lane, w = F.wave, r32 = lane & 31, hi = lane >> 5;
    const size_t tok0 = (size_t)b * SEQ; const int q0 = qb * 256 + w * 32, NT = 4 * qb + 4;
    bf16x8 qf[6];
#pragma unroll
    for (int ks = 0; ks < 6; ++ks) qf[ks] = *(const bf16x8*)(Q + ((tok0 + q0 + r32) * 16 + h) * 96 + 16 * ks + 8 * hi);
    const int kk0 = tid / 12, kp0 = tid % 12, kk1 = (tid + 512) / 12, kp1 = (tid + 512) % 12, vk = tid >> 3, vp = tid & 7;
    const bf16_t* kg0 = K + ((tok0 + kk0) * 16 + h) * 96 + kp0 * 8; const bf16_t* kg1 = K + ((tok0 + kk1) * 16 + h) * 96 + kp1 * 8; const bf16_t* vg = V + ((tok0 + vk) * 16 + h) * 64 + vp * 8;
    const int kl0 = kk0 * 208 + kp0 * 16, kl1 = kk1 * 208 + kp1 * 16, vl = vk * 192 + vp * 16;
    const size_t tstepK = (size_t)64 * 16 * 96, tstepV = (size_t)64 * 16 * 64;
    u32x4 rk0, rk1 = (u32x4){0u, 0u, 0u, 0u}, rv;
    rk0 = *(const u32x4*)kg0; if (tid < 256) rk1 = *(const u32x4*)kg1; rv = *(const u32x4*)vg;
    *(LAS u32x4*)(F.lds + AT_K + kl0) = rk0; if (tid < 256) *(LAS u32x4*)(F.lds + AT_K + kl1) = rk1; *(LAS u32x4*)(F.lds + AT_V + vl) = rv;
    __syncthreads();
    float m_run = -INFINITY, l_run = 0.f; f32x16 o0 = zero16(), o1 = zero16();
    for (int t = 0; t < NT; ++t) {
        const int cur = t & 1;
        if (t + 1 < NT) { rk0 = *(const u32x4*)(kg0 + (size_t)(t + 1) * tstepK); if (tid < 256) rk1 = *(const u32x4*)(kg1 + (size_t)(t + 1) * tstepK); rv = *(const u32x4*)(vg + (size_t)(t + 1) * tstepV); }
        if (64 * t <= q0 + 31) {
            LAS const unsigned char* Kb = F.lds + AT_K + cur * AT_KB; LAS const unsigned char* Vb = F.lds + AT_V + cur * AT_VB;
            f32x16 p0 = zero16(), p1 = zero16();
#pragma unroll
            for (int ks = 0; ks < 6; ++ks) { p0 = MFMA32(row_frag(Kb, 208, 0, 16 * ks, lane), qf[ks], p0); p1 = MFMA32(row_frag(Kb, 208, 32, 16 * ks, lane), qf[ks], p1); }
            if (64 * t + 63 > q0) {
                const int qa = q0 + r32;
#pragma unroll
                for (int r = 0; r < 16; ++r) { const int ka = 64 * t + crow(r, hi); if (ka > qa) p0[r] = -INFINITY; if (ka + 32 > qa) p1[r] = -INFINITY; }
            }
            float mx = fmaxf(p0[0], p1[0]);
#pragma unroll
            for (int r = 1; r < 16; ++r) mx = fmaxf(mx, fmaxf(p0[r], p1[r]));
            mx = fmaxf(mx, lane_xor(mx, 32, lane));
            const float m_new = fmaxf(m_run, mx), alpha = __builtin_amdgcn_exp2f(m_run - m_new); m_run = m_new;
            float sum = 0.f;
#pragma unroll
            for (int r = 0; r < 16; ++r) { p0[r] = __builtin_amdgcn_exp2f(p0[r] - m_new); p1[r] = __builtin_amdgcn_exp2f(p1[r] - m_new); sum += p0[r] + p1[r]; }
            l_run = l_run * alpha + sum;
#pragma unroll
            for (int r = 0; r < 16; ++r) { o0[r] *= alpha; o1[r] *= alpha; }
#pragma unroll
            for (int s = 0; s < 2; ++s) {
                bf16x8 pb0, pb1;
                { u32x4 x; x.x = pkbf(p0[8 * s + 0], p0[8 * s + 1]); x.y = pkbf(p0[8 * s + 2], p0[8 * s + 3]); x.z = pkbf(p0[8 * s + 4], p0[8 * s + 5]); x.w = pkbf(p0[8 * s + 6], p0[8 * s + 7]); pb0 = __builtin_bit_cast(bf16x8, x); }
                { u32x4 x; x.x = pkbf(p1[8 * s + 0], p1[8 * s + 1]); x.y = pkbf(p1[8 * s + 2], p1[8 * s + 3]); x.z = pkbf(p1[8 * s + 4], p1[8 * s + 5]); x.w = pkbf(p1[8 * s + 6], p1[8 * s + 7]); pb1 = __builtin_bit_cast(bf16x8, x); }
                o0 = MFMA32(tr_frag_acc(Vb, 192, 16 * s, 0, lane), pb0, o0);      o1 = MFMA32(tr_frag_acc(Vb, 192, 16 * s, 32, lane), pb0, o1);
                o0 = MFMA32(tr_frag_acc(Vb, 192, 32 + 16 * s, 0, lane), pb1, o0); o1 = MFMA32(tr_frag_acc(Vb, 192, 32 + 16 * s, 32, lane), pb1, o1);
            }
        }
        if (t + 1 < NT) { const int nx = cur ^ 1; *(LAS u32x4*)(F.lds + AT_K + nx * AT_KB + kl0) = rk0; if (tid < 256) *(LAS u32x4*)(F.lds + AT_K + nx * AT_KB + kl1) = rk1; *(LAS u32x4*)(F.lds + AT_V + nx * AT_VB + vl) = rv; }
        __syncthreads();
    }
    l_run += lane_xor(l_run, 32, lane);
    const float inv = 1.0f / l_run;
    LAS bf16_t* stg = (LAS bf16_t*)(F.lds + AT_O + w * 4096);
#pragma unroll
    for (int r = 0; r < 16; ++r) { const int d = crow(r, hi); stg[r32 * 64 + d] = (bf16_t)(pkbf(o0[r] * inv, 0.f) & 0xffffu); stg[r32 * 64 + 32 + d] = (bf16_t)(pkbf(o1[r] * inv, 0.f) & 0xffffu); }
    LDS_WAIT(); asm volatile("" ::: "memory");
#pragma unroll
    for (int i = 0; i < 4; ++i) { const int row = i * 8 + (lane >> 3), ch = lane & 7; *(u32x4*)(O + ((tok0 + q0 + row) * 16 + h) * 64 + ch * 8) = *(LAS const u32x4*)(stg + row * 64 + ch * 8); }
    __syncthreads();
}
__device__ __forceinline__ void attn_phase(const Ctx& F, const bf16_t* Q, const bf16_t* K, const bf16_t* V, bf16_t* O) {
    const int bh = F.vcu >> 2, s = F.vcu & 3;
    if (bh >= NBATCH * 16) return;
#pragma unroll 1
    for (int i = 0; i < 4; ++i) { const int qb = (i == 0) ? s : (i == 1) ? 7 - s : (i == 2) ? 8 + s : 15 - s; attn_unit(F, bh >> 4, bh & 15, qb, Q, K, V, O); }
}

__device__ __forceinline__ void moe_route(const Ctx& F, const float* x, const float* g, const float* Wr, unsigned* CNT, float* RSTD, int* TOKE, int* TOKP, float* TOKW) {
    const int gw = F.vcu * NWAVES + F.wave, NGW = F.G * NWAVES, lane = F.lane;
    f32x4 gv[4];
#pragma unroll
    for (int j = 0; j < 4; ++j) gv[j] = ((const f32x4*)g)[lane + 64 * j];
    for (int m = gw; m < NTOK; m += NGW) {
        const f32x4* xr = (const f32x4*)(x + (size_t)m * DM) + lane;
        f32x4 v[4]; float s = 0.f;
#pragma unroll
        for (int j = 0; j < 4; ++j) { v[j] = xr[64 * j]; s += (v[j].x * v[j].x + v[j].y * v[j].y) + (v[j].z * v[j].z + v[j].w * v[j].w); }
        const float rstd = 1.0f / sqrtf(wave_sum(s, lane) * (1.0f / DM) + RMS_EPS);
        float lg[8];
#pragma unroll
        for (int e = 0; e < 8; ++e) lg[e] = 0.f;
#pragma unroll
        for (int j = 0; j < 4; ++j) { const float hv[4] = {v[j].x * rstd * gv[j].x, v[j].y * rstd * gv[j].y, v[j].z * rstd * gv[j].z, v[j].w * rstd * gv[j].w};
#pragma unroll
            for (int i = 0; i < 4; ++i) { const float* wr = Wr + (size_t)(4 * (lane + 64 * j) + i) * 8; const f32x4 a = *(const f32x4*)wr, bq = *(const f32x4*)(wr + 4);
                lg[0] += hv[i] * a.x; lg[1] += hv[i] * a.y; lg[2] += hv[i] * a.z; lg[3] += hv[i] * a.w; lg[4] += hv[i] * bq.x; lg[5] += hv[i] * bq.y; lg[6] += hv[i] * bq.z; lg[7] += hv[i] * bq.w; } }
#pragma unroll
        for (int e = 0; e < 8; ++e) lg[e] = wave_sum(lg[e], lane);
        int i0 = 0; float v0 = lg[0];
#pragma unroll
        for (int e = 1; e < 8; ++e) if (lg[e] > v0) { v0 = lg[e]; i0 = e; }
        int i1 = -1; float v1 = -INFINITY;
#pragma unroll
        for (int e = 0; e < 8; ++e) if (e != i0 && lg[e] > v1) { v1 = lg[e]; i1 = e; }
        if (lane == 0) {
            const float w0 = 1.0f / (1.0f + __expf(v1 - v0));
            const unsigned p0 = atomicAdd(CNT + 64 * i0, 1u), p1 = atomicAdd(CNT + 64 * i1, 1u);
            RSTD[m] = rstd; TOKE[2 * m] = i0; TOKE[2 * m + 1] = i1; TOKP[2 * m] = (int)p0; TOKP[2 * m + 1] = (int)p1; TOKW[2 * m] = w0; TOKW[2 * m + 1] = 1.0f - w0;
        }
    }
}
__device__ __forceinline__ void moe_offsets(const unsigned* CNT, int (&off)[9]) {
    off[0] = 0;
#pragma unroll
    for (int e = 0; e < 8; ++e) { const unsigned c = __hip_atomic_load(CNT + 64 * e, __ATOMIC_RELAXED, __HIP_MEMORY_SCOPE_AGENT); off[e + 1] = off[e] + __builtin_amdgcn_readfirstlane((int)((c + 255u) & ~255u)); }
}
__device__ __forceinline__ void moe_scatter(const Ctx& F, const float* x, const float* g, const unsigned* CNT, const float* RSTD, const int* TOKE, const int* TOKP, int* TOKR, bf16_t* AG) {
    const int gw = F.vcu * NWAVES + F.wave, NGW = F.G * NWAVES, lane = F.lane;
    int off[9]; moe_offsets(CNT, off);
    f32x4 gv[4];
#pragma unroll
    for (int j = 0; j < 4; ++j) gv[j] = ((const f32x4*)g)[lane + 64 * j];
    for (int m = gw; m < NTOK; m += NGW) {
        const f32x4* xr = (const f32x4*)(x + (size_t)m * DM) + lane; const float rstd = RSTD[m];
        const int e0 = TOKE[2 * m], e1 = TOKE[2 * m + 1]; int r0 = TOKP[2 * m], r1 = TOKP[2 * m + 1];
#pragma unroll
        for (int e = 0; e < 8; ++e) { if (e == e0) r0 += off[e]; if (e == e1) r1 += off[e]; }
        if (lane == 0) { TOKR[2 * m] = r0; TOKR[2 * m + 1] = r1; }
        u32x2* o0 = (u32x2*)(AG + (size_t)r0 * DM) + lane; u32x2* o1 = (u32x2*)(AG + (size_t)r1 * DM) + lane;
#pragma unroll
        for (int j = 0; j < 4; ++j) { const f32x4 v = xr[64 * j]; u32x2 wv; wv.x = pkbf(v.x * rstd * gv[j].x, v.y * rstd * gv[j].y); wv.y = pkbf(v.z * rstd * gv[j].z, v.w * rstd * gv[j].w); o0[64 * j] = wv; o1[64 * j] = wv; }
    }
}
__device__ __forceinline__ void moe_combine(const Ctx& F, float* x, const bf16_t* YP, const int* TOKR, const float* TOKW) {
    const int gw = F.vcu * NWAVES + F.wave, NGW = F.G * NWAVES, lane = F.lane;
    for (int m = gw; m < NTOK; m += NGW) {
        const int r0 = TOKR[2 * m], r1 = TOKR[2 * m + 1]; const float w0 = TOKW[2 * m], w1 = TOKW[2 * m + 1];
        f32x4* xr = (f32x4*)(x + (size_t)m * DM) + lane; const u32x2* y0 = (const u32x2*)(YP + (size_t)r0 * DM) + lane; const u32x2* y1 = (const u32x2*)(YP + (size_t)r1 * DM) + lane;
#pragma unroll
        for (int j = 0; j < 4; ++j) { f32x4 v = xr[64 * j]; const u32x2 a = y0[64 * j], c = y1[64 * j];
            v.x += w0 * bflo(a.x) + w1 * bflo(c.x); v.y += w0 * bfhi(a.x) + w1 * bfhi(c.x); v.z += w0 * bflo(a.y) + w1 * bflo(c.y); v.w += w0 * bfhi(a.y) + w1 * bfhi(c.y); xr[64 * j] = v; }
    }
}

#ifndef MK_N_LAUNCHES
#define MK_N_LAUNCHES 25
#endif
constexpr int PH_L0 = 11, PH_L1 = 13, N_PHASES = 1 + PH_L0 + PH_L1;
struct Args { const float* in[31]; float* out; unsigned char* ws; int ph_lo, ph_hi, use_bar, pad; };


typedef const __attribute__((address_space(4))) Args* cargs_t;
__device__ __forceinline__ cargs_t kargs() { cargs_t p = (cargs_t)__builtin_amdgcn_kernarg_segment_ptr(); asm volatile("" : "+s"(p)); return p; }
#define AIN(i) ((const float*)kargs()->in[i])
#define AWS ((unsigned char*)kargs()->ws)
__device__ __forceinline__ unsigned char* opq(unsigned char* p) { asm volatile("" : "+s"(p)); return p; }
#ifndef EN_MASK
#define EN_MASK 0xFFFFFFFFu
#endif
#define EN(b) (((EN_MASK) >> (b)) & 1u)
#define WSV(type, off) ((type*)(opq(AWS) + (off)))
__global__ void __launch_bounds__(NTHREADS, 2) mk_fwd(Args args) {
    extern __shared__ __attribute__((aligned(16))) unsigned char lds_raw[];
    volatile LAS unsigned* MISCW = (volatile LAS unsigned*)((LAS unsigned char*)lds_raw + LDS_MISC_OFF);
    if (threadIdx.x < 32) MISCW[threadIdx.x] = 0u;
    __syncthreads();
    if (kargs()->use_bar) (void)xcd_barrier_post((unsigned*)(AWS + WS_CTL) + CW_BAR, MISCW + 8);
#pragma unroll 1
    for (int ph = kargs()->ph_lo; ph < kargs()->ph_hi; ++ph) {
        Ctx F; { int t_ = threadIdx.x, bx = blockIdx.x, gd = gridDim.x; asm volatile("" : "+v"(t_)); asm volatile("" : "+s"(bx), "+s"(gd));
                 F.lds = (LAS unsigned char*)lds_raw; F.tid = t_; F.lane = t_ & 63; F.wave = __builtin_amdgcn_readfirstlane(t_ >> 6); F.G = gd; F.vcu = (gd % 8 == 0) ? (bx % 8) * (gd / 8) + bx / 8 : bx; F.bx = bx; }
        const int L = (ph > PH_L0) ? 1 : 0, k = (ph == 0) ? -1 : (ph - 1 - L * PH_L0);
        float* X = kargs()->out;
        const float* xin = (L == 0) ? AIN(0) : X;
        const size_t wlo = WS_WL0 + (size_t)L * WS_WL_STRIDE;
        if (EN(0) && k == -1) {
#pragma unroll 1
            for (int l2 = 0; l2 < 2; ++l2) {
                unsigned char* wl = opq(AWS) + WS_WL0 + (size_t)l2 * WS_WL_STRIDE;
                convert_matrix<1>(F, AIN(2) + (size_t)l2 * DM * NIN, DM, NIN, (bf16_t*)(wl + WO_WIN));
                convert_matrix<0>(F, AIN(14) + (size_t)l2 * 256 * 1536, 256, 1536, (bf16_t*)(wl + WO_WUQ));
                convert_matrix<0>(F, AIN(16) + (size_t)l2 * 128 * 2048, 128, 2048, (bf16_t*)(wl + WO_WUKV));
                convert_matrix<0>(F, AIN(19) + (size_t)l2 * DM * DM, DM, DM, (bf16_t*)(wl + WO_WBR));
                convert_matrix<0>(F, AIN(20) + (size_t)l2 * DM * DM, DM, DM, (bf16_t*)(wl + WO_WBR + 2 * MiB));
                convert_matrix<0>(F, AIN(21) + (size_t)l2 * DM * DM, DM, DM, (bf16_t*)(wl + WO_WBR + 4 * MiB));
                convert_matrix<0>(F, AIN(22) + (size_t)l2 * DM * DM, DM, DM, (bf16_t*)(wl + WO_WOUT));
                for (int i = F.vcu * NTHREADS + F.tid; i < 80 * DM / 8; i += F.G * NTHREADS) ((u32x4*)(wl + WO_WIN + (size_t)2736 * DM * 2))[i] = (u32x4){0u, 0u, 0u, 0u};
            }
            convert_matrix<2>(F, AIN(24), DM, FFD, WSV(bf16_t, WS_WGU));
            convert_matrix<3>(F, AIN(25), DM, FFD, WSV(bf16_t, WS_WGU));
            convert_matrix<0>(F, AIN(26), FFD, DM, WSV(bf16_t, WS_WDN));
            float* ROPE = WSV(float, WS_ROPE);
            for (int i = F.vcu * NTHREADS + F.tid; i < SEQ * 16; i += F.G * NTHREADS) { const int pos = i >> 4, kk = i & 15;
                const float inv = __builtin_amdgcn_exp2f(-(float)kk * (13.287712379549449f / 16.0f)), ang = (float)pos * inv; float rev = ang * 0.15915494309189535f; rev -= floorf(rev); ROPE[2 * i] = __builtin_amdgcn_cosf(rev); ROPE[2 * i + 1] = __builtin_amdgcn_sinf(rev); }
            __syncthreads();
        }
        else if (EN(1) && k == 0) {
            rmsnorm_rows(F, xin, AIN(1) + L * DM, WSV(bf16_t, WS_H));
        }
        else if (EN(2) && k == 1) {
            pg8::Gemm g{WSV(bf16_t, WS_H), WSV(bf16_t, wlo + WO_WIN), NTOK, 20 * 256, DM}; pg8::StaticOrder S; S.init(NTOK, 20 * 256, F.G, F.bx);
            pg8::EpiIn E{WSV(bf16_t, WS_Z), WSV(bf16_t, WS_XBC), WSV(bf16_t, WS_QLAT), WSV(bf16_t, WS_U), WSV(bf16_t, WS_V), WSV(bf16_t, WS_GATES), WSV(float, WS_MISC), 0};
            pg8::gemm_phase<pg8::EpiIn, pg8::StaticOrder, true, true>(F.lds, g, S, E);
        }
        else if (EN(3) && k == 2) {
            mixer_rowpass(F, WSV(bf16_t, WS_QLAT), WSV(float, WS_MISC), WSV(bf16_t, WS_V), AIN(13) + L * 256, AIN(15) + L * 128, WSV(bf16_t, WS_AQ), WSV(bf16_t, WS_AKV), WSV(float, WS_VSTAT));
            ssd_pass_a(F, WSV(bf16_t, WS_XBC), WSV(float, WS_MISC), AIN(3) + L * 4 * 1536, AIN(4) + L * 1536, AIN(5) + L * 16, AIN(6) + L * 16,
                       WSV(bf16_t, WS_STATES), WSV(float, WS_CSG), WSV(float, WS_DTG), WSV(float, WS_CDEC));
        }
        else if (EN(4) && k == 3) {
#pragma unroll 1
            for (int i = 0; i < 2; ++i) {
                if (!(i == 0 ? EN(11) : EN(12))) continue;
                const int n = i ? 2048 : 1536, kd = i ? 128 : 256;
                pg8::Gemm g{WSV(bf16_t, i ? WS_AKV : WS_AQ), WSV(bf16_t, wlo + (i ? WO_WUKV : WO_WUQ)), NTOK, n, kd}; pg8::StaticOrder S; S.init(NTOK, n, F.G, F.bx);
                pg8::EpiPlain E{WSV(bf16_t, i ? WS_KVRAW : WS_QRAW), n};
                pg8::gemm_phase<pg8::EpiPlain, pg8::StaticOrder, true, true>(F.lds, g, S, E);
            }
            if (EN(13)) ssd_scan(F, WSV(bf16_t, WS_STATES), WSV(float, WS_CDEC));
            if (EN(14)) sgu_phase(F, WSV(bf16_t, WS_U), WSV(bf16_t, WS_V), WSV(float, WS_VSTAT), AIN(9) + L * 1024, AIN(10) + L * 1024, AIN(11) + (size_t)L * 8 * 128 * 128, AIN(12) + L * 8 * 128);
        }
        else if (EN(5) && k == 4) {
            if (EN(15)) qk_finalize(F, WSV(bf16_t, WS_QRAW), WSV(bf16_t, WS_KVRAW), WSV(float, WS_MISC), AIN(17) + L * 96, AIN(18) + L * 96, WSV(float, WS_ROPE), WSV(bf16_t, WS_K), WSV(bf16_t, WS_VM));
            if (EN(16)) ssd_pass_c(F, WSV(bf16_t, WS_XBC), WSV(bf16_t, WS_STATES), WSV(float, WS_CSG), WSV(float, WS_DTG), WSV(bf16_t, WS_Z), AIN(3) + L * 4 * 1536, AIN(4) + L * 1536,
                       AIN(7) + L * 16, AIN(8) + L * 1024, WSV(bf16_t, WS_YSSD));
        }
        else if (EN(6) && k == 5) {
            attn_phase(F, WSV(bf16_t, WS_QRAW), WSV(bf16_t, WS_K), WSV(bf16_t, WS_VM), WSV(bf16_t, WS_O));
        }
        else if (EN(7) && k == 6) {
            { pg8::Gemm g{WSV(bf16_t, WS_H), WSV(bf16_t, wlo + WO_WIN) + (size_t)20 * 256 * DM, NTOK, 12 * 256, DM}; pg8::GateOrder S; S.so.init(NTOK, DM, F.G, F.bx);
              pg8::EpiIn E{nullptr, nullptr, nullptr, nullptr, nullptr, WSV(bf16_t, WS_GATES), nullptr, 20};
              pg8::gemm_phase<pg8::EpiIn, pg8::GateOrder, true, true>(F.lds, g, S, E); }
#pragma unroll 1
            for (int i = 0; i < 3; ++i) {
                const bf16_t* A = WSV(bf16_t, (i == 0) ? WS_YSSD : (i == 1) ? WS_U : WS_O);
                pg8::Gemm g{A, WSV(bf16_t, wlo + WO_WBR + (size_t)i * 2 * MiB), NTOK, DM, DM}; pg8::StaticOrder S; S.init(NTOK, DM, F.G, F.bx);
                pg8::EpiGate E{WSV(bf16_t, WS_MERGED), WSV(bf16_t, WS_GATES), i * 1024, i};
                pg8::gemm_phase<pg8::EpiGate, pg8::StaticOrder, true, true>(F.lds, g, S, E);
            }
        }
        else if (EN(8) && k == 7) {
            pg8::Gemm g{WSV(bf16_t, WS_MERGED), WSV(bf16_t, wlo + WO_WOUT), NTOK, DM, DM}; pg8::StaticOrder S; S.init(NTOK, DM, F.G, F.bx); pg8::EpiResid E{xin, X};
            pg8::gemm_phase<pg8::EpiResid, pg8::StaticOrder, true, true>(F.lds, g, S, E);
        }
        else if (EN(9) && L == 0 && k == 8) { rmsnorm_rows(F, X, AIN(23), WSV(bf16_t, WS_H)); }
        else if (EN(9) && L == 0 && k == 9) {
            pg8::Gemm g{WSV(bf16_t, WS_H), WSV(bf16_t, WS_WGU), NTOK, 2 * FFD, DM}; pg8::StaticOrder S; S.init(NTOK, 2 * FFD, F.G, F.bx); pg8::EpiSwiglu E{WSV(bf16_t, WS_HID), FFD};
            pg8::gemm_phase<pg8::EpiSwiglu, pg8::StaticOrder, true, true>(F.lds, g, S, E);
        }
        else if (EN(9) && L == 0 && k == 10) {
            pg8::Gemm g{WSV(bf16_t, WS_HID), WSV(bf16_t, WS_WDN), NTOK, DM, FFD}; pg8::StaticOrder S; S.init(NTOK, DM, F.G, F.bx); pg8::EpiResid E{X, X};
            pg8::gemm_phase<pg8::EpiResid, pg8::StaticOrder, true, true>(F.lds, g, S, E);
        }
        else if (EN(10) && L == 1 && k == 8) {
            if (EN(17)) moe_route(F, X, AIN(23) + DM, AIN(27), WSV(unsigned, WS_CTL) + CW_CNT, WSV(float, WS_RSTD), WSV(int, WS_TOKE), WSV(int, WS_TOKP), WSV(float, WS_TOKW));
#pragma unroll 1
            for (int e = 0; e < (EN(18) ? NEXP : 0); ++e) {
                convert_matrix<2>(F, AIN(28) + (size_t)e * DM * FFE, DM, FFE, WSV(bf16_t, WS_WMGU) + (size_t)e * 2 * FFE * DM);
                convert_matrix<3>(F, AIN(29) + (size_t)e * DM * FFE, DM, FFE, WSV(bf16_t, WS_WMGU) + (size_t)e * 2 * FFE * DM);
                convert_matrix<0>(F, AIN(30) + (size_t)e * FFE * DM, FFE, DM, WSV(bf16_t, WS_WMDN) + (size_t)e * DM * FFE);
            }
            __syncthreads();
        }
        else if (EN(10) && EN(19) && L == 1 && k == 9) {
            moe_scatter(F, X, AIN(23) + DM, WSV(unsigned, WS_CTL) + CW_CNT, WSV(float, WS_RSTD), WSV(int, WS_TOKE), WSV(int, WS_TOKP), WSV(int, WS_TOKR), WSV(bf16_t, WS_AG));
        }
        else if (EN(10) && EN(20) && L == 1 && k == 10) {
            int off[9]; moe_offsets(WSV(unsigned, WS_CTL) + CW_CNT, off);
            pg8::Gemm g{WSV(bf16_t, WS_AG), WSV(bf16_t, WS_WMGU), off[8], 2 * FFE, DM}; pg8::MoeOrder S; S.so.init(off[8], 2 * FFE, F.G, F.bx); S.estride = (size_t)2 * FFE * DM * 2;
#pragma unroll
            for (int e = 0; e < 9; ++e) S.toff[e] = off[e] >> 8;
            pg8::EpiSwiglu E{WSV(bf16_t, WS_HIDM), FFE};
            pg8::gemm_phase<pg8::EpiSwiglu, pg8::MoeOrder, true, true>(F.lds, g, S, E);
        }
        else if (EN(10) && EN(21) && L == 1 && k == 11) {
            int off[9]; moe_offsets(WSV(unsigned, WS_CTL) + CW_CNT, off);
            pg8::Gemm g{WSV(bf16_t, WS_HIDM), WSV(bf16_t, WS_WMDN), off[8], DM, FFE}; pg8::MoeOrder S; S.so.init(off[8], DM, F.G, F.bx); S.estride = (size_t)DM * FFE * 2;
#pragma unroll
            for (int e = 0; e < 9; ++e) S.toff[e] = off[e] >> 8;
            pg8::EpiPlain E{WSV(bf16_t, WS_YP), DM};
            pg8::gemm_phase<pg8::EpiPlain, pg8::MoeOrder, true, true>(F.lds, g, S, E);
        }
        else if (EN(10) && EN(22) && L == 1 && k == 12) {
            moe_combine(F, X, WSV(bf16_t, WS_YP), WSV(int, WS_TOKR), WSV(float, WS_TOKW));
        }
        if (ph + 1 < kargs()->ph_hi) { XcdBarrier b2; b2.bar = (unsigned*)(opq(AWS) + WS_CTL) + CW_BAR; b2.x = xb_xcc_id(); b2.st = MISCW + 8; xcd_barrier(b2); }
    }
}

extern "C" void kernel_launch(void* const* d_in, const int* in_sizes, int n_in, void* d_out, int out_size, void* d_ws, size_t ws_size, hipStream_t stream) {
    static int grid = 0;
    if (grid == 0) {
        if (n_in != 31 || in_sizes[0] != NTOK * DM || out_size != NTOK * DM || ws_size < WS_END) {
            fprintf(stderr, "kernel_launch: unexpected problem (n_in %d, in0 %d, out %d, ws %zu < %zu?); nothing launched\n", n_in, n_in > 0 ? in_sizes[0] : -1, out_size, ws_size, (size_t)WS_END); grid = -1; return; }
        int dev = 0, cus = 0, per_cu = 0;
        if (hipGetDevice(&dev) != hipSuccess || hipDeviceGetAttribute(&cus, hipDeviceAttributeMultiprocessorCount, dev) != hipSuccess) { grid = -1; return; }
        if (hipFuncSetAttribute((const void*)mk_fwd, hipFuncAttributeMaxDynamicSharedMemorySize, LDS_BYTES) != hipSuccess) { fprintf(stderr, "kernel_launch: hipFuncSetAttribute failed\n"); grid = -1; return; }
        if (hipOccupancyMaxActiveBlocksPerMultiprocessor(&per_cu, (const void*)mk_fwd, NTHREADS, LDS_BYTES) != hipSuccess || per_cu < 1) fprintf(stderr, "kernel_launch: occupancy query reports %d blocks per CU\n", per_cu);
        (void)hipGetLastError();
        grid = cus;
        if (grid != 256) { fprintf(stderr, "kernel_launch: this kernel is built for a 256-CU device (got %d)\n", grid); grid = -1; return; }
    }
    if (grid < 0) return;
    if (hipMemsetAsync((char*)d_ws + WS_CTL, 0, CTL_ZERO_BYTES, stream) != hipSuccess) return;
    Args a{};
    for (int i = 0; i < 31; ++i) a.in[i] = (const float*)d_in[i];
    a.out = (float*)d_out; a.ws = (unsigned char*)d_ws;
#if MK_N_LAUNCHES == 1
    a.ph_lo = 0; a.ph_hi = N_PHASES; a.use_bar = 1;
    hipLaunchKernelGGL(mk_fwd, dim3(grid), dim3(NTHREADS), LDS_BYTES, stream, a);
#else
    for (int p = 0; p < N_PHASES; ++p) { a.ph_lo = p; a.ph_hi = p + 1; a.use_bar = 0; hipLaunchKernelGGL(mk_fwd, dim3(grid), dim3(NTHREADS), LDS_BYTES, stream, a); }
#endif
}
```

```cpp
#include <hip/hip_runtime.h>
#include <cstdio>
#include <cstdint>
namespace pg8 {
#define PG8_LAS __attribute__((address_space(3)))
typedef unsigned short bf16_t;
typedef short bf16x8 __attribute__((ext_vector_type(8)));
typedef float f32x4 __attribute__((ext_vector_type(4)));
typedef unsigned u32x4 __attribute__((ext_vector_type(4)));
constexpr int BM = 256, BK = 64, HALF = 128, HTB = HALF * BK * 2  , STAGE_BYTES = 8 * HTB, NXCD = 8, WGM = 2;

__host__ __device__ __forceinline__ int lds_byte(int r, int c) { const int st = (r >> 4) * 2 + (c >> 5), rr = r & 15, cc = c & 31, ob = rr * 64 + cc * 2; return st * 1024 + (ob ^ (((ob >> 9) & 1) << 5)); }
__host__ __device__ __forceinline__ void stage_rc(int b, int& R, int& C) { const int st = b / 1024, sb = b % 1024, swz = sb ^ (((sb >> 9) & 1) << 5); R = (st >> 1) * 16 + swz / 64; C = (st & 1) * 32 + (swz % 64) / 2; }
__host__ __device__ __forceinline__ int perm32(int rho) { const int n = rho >> 4, i = rho & 15; return 8 * (i >> 2) + 4 * n + (i & 3); }

struct Unit { int pm, pn; };
struct Gemm { const bf16_t* A; const bf16_t* Bt; int M, N, K, ld; };

struct StaticOrder {
    int nM, nN, nwg, G, c;
    __host__ __device__ void init(int M, int N, int G_, int c_) { nM = M / BM; nN = N / BM; nwg = nM * nN; G = G_; c = c_; }
    __host__ __device__ bool next(int i, Unit& u) const {
        const long L = (long)i * G + c; if (L >= nwg) return false;
        int wgid = (int)L; { const int q = nwg / NXCD, r = nwg % NXCD, xcd = wgid % NXCD, off = wgid / NXCD; wgid = (xcd < r ? xcd * (q + 1) : r * (q + 1) + (xcd - r) * q) + off; }
        const int nig = WGM * nN, gid = wgid / nig, fm = gid * WGM, gsz = (nM - fm) < WGM ? (nM - fm) : WGM;
        u.pm = fm + ((wgid % nig) % gsz); u.pn = (wgid % nig) / gsz; return true;
    }
    __device__ __forceinline__ void a_ready(const Unit&) const {}
    __device__ __forceinline__ size_t b_off(const Unit&) const { return 0; }
    __device__ __forceinline__ size_t a_off(const Unit&) const { return 0; }
    __device__ __forceinline__ void done(const Unit&) const {}
};

__device__ __forceinline__ unsigned cvt_pk_bf16(float lo, float hi) { unsigned r; asm volatile("v_cvt_pk_bf16_f32 %0, %1, %2" : "=v"(r) : "v"(lo), "v"(hi)); return r; }
typedef float f32x2 __attribute__((ext_vector_type(2)));
__device__ __forceinline__ f32x2 gelu_pk(f32x2 v) {
    const f32x2 av = __builtin_elementwise_abs(v), d = av * 0.2316418882f + 1.0f;
    f32x2 t; t.x = __builtin_amdgcn_rcpf(d.x); t.y = __builtin_amdgcn_rcpf(d.y);
    f32x2 q = t * 0.5307027145f + (-0.7265760135f); q = q * t + 0.7107068705f; q = q * t + (-0.142248368f); q = q * t + 0.127414796f; q = q * t;
    const f32x2 s = (v * v) * (-0.72134752044f);
    f32x2 e; e.x = __builtin_amdgcn_exp2f(s.x); e.y = __builtin_amdgcn_exp2f(s.y);
    const f32x2 m = v * (q * e), r = v - m;
    f32x2 o; o.x = v.x < 0.f ? m.x : r.x; o.y = v.y < 0.f ? m.y : r.y; return o;
}

__device__ __forceinline__ unsigned pkbf(float lo, float hi) { typedef __bf16 b2_t __attribute__((ext_vector_type(2))); f32x2 v = {lo, hi}; b2_t b = __builtin_convertvector(v, b2_t); return __builtin_bit_cast(unsigned, b); }
__device__ __forceinline__ float bflo(unsigned w) { return __uint_as_float(w << 16); }
__device__ __forceinline__ float bfhi(unsigned w) { return __uint_as_float(w & 0xffff0000u); }
__device__ __forceinline__ float fsigmoid(float x) { return __builtin_amdgcn_rcpf(1.0f + __builtin_amdgcn_exp2f(-1.4426950408889634f * x)); }
template <int ACT> __device__ __forceinline__ f32x4 act4(f32x4 v) {
    if (ACT == 1) { v[0] *= fsigmoid(v[0]); v[1] *= fsigmoid(v[1]); v[2] *= fsigmoid(v[2]); v[3] *= fsigmoid(v[3]); }
    if (ACT == 2) { const f32x2 a = gelu_pk((f32x2){v[0], v[1]}), b = gelu_pk((f32x2){v[2], v[3]}); v = (f32x4){a.x, a.y, b.x, b.y}; }
    if (ACT == 3) { v[0] = fsigmoid(v[0]); v[1] = fsigmoid(v[1]); v[2] = fsigmoid(v[2]); v[3] = fsigmoid(v[3]); }
    return v;
}
__device__ __forceinline__ void row_scales(const float* ssq, int row0, float (&rs)[2][4]) {
#pragma unroll
    for (int ai = 0; ai < 2; ++ai)
#pragma unroll
        for (int m = 0; m < 4; ++m) { float s = 1.0f;
            if (ssq) { const f32x4* p = (const f32x4*)(ssq + (size_t)(row0 + ai * HALF + m * 16) * 16); const f32x4 a = p[0], b = p[1], c = p[2], d = p[3];
                s = 1.0f / sqrtf((((a.x + a.y) + (a.z + a.w)) + ((b.x + b.y) + (b.z + b.w)) + ((c.x + c.y) + (c.z + c.w)) + ((d.x + d.y) + (d.z + d.w))) * (1.0f / 1024.0f) + 1e-6f); }
            rs[ai][m] = s; }
}
template <int ACT> __device__ __forceinline__ void store_tile_bf16(const f32x4 (&acc)[2][2][4][2], bf16_t* base, int ld, int row0, int col0, const float (&rs)[2][4]) {
#pragma unroll
    for (int ai = 0; ai < 2; ++ai)
#pragma unroll
        for (int m = 0; m < 4; ++m) { bf16_t* rowp = base + (size_t)(row0 + ai * HALF + m * 16) * ld + col0;
#pragma unroll
            for (int bj = 0; bj < 2; ++bj) { const f32x4 v0 = act4<ACT>(acc[ai][bj][m][0] * rs[ai][m]), v1 = act4<ACT>(acc[ai][bj][m][1] * rs[ai][m]);
                u32x4 w; w.x = pkbf(v0[0], v0[1]); w.y = pkbf(v0[2], v0[3]); w.z = pkbf(v1[0], v1[1]); w.w = pkbf(v1[2], v1[3]);
                *(u32x4*)(rowp + bj * HALF) = w; } }
}
struct EpiIn {
    static constexpr bool PERM = true, AFTER_DRAIN = false;
    bf16_t *Z, *XBC, *QLAT, *U, *V, *GATES; float* MISC; int pn_base; const float* ssq;
    __device__ __forceinline__ void operator()(const f32x4 (&acc)[2][2][4][2], const Unit& u, int wr, int wc, int fr, int fq) const {
        const int pn = u.pn + pn_base, row0 = u.pm * BM + wr * 64 + fr, cw = wc * 32 + 8 * fq;
        float rs[2][4]; row_scales(ssq, row0, rs);
        if (pn < 4) store_tile_bf16<1>(acc, Z, 1024, row0, pn * 256 + cw, rs);
        else if (pn < 10) store_tile_bf16<0>(acc, XBC, 1536, row0, (pn - 4) * 256 + cw, rs);
        else if (pn == 10) {
#pragma unroll
            for (int ai = 0; ai < 2; ++ai)
#pragma unroll
                for (int m = 0; m < 4; ++m) { float* rowp = MISC + (size_t)(row0 + ai * HALF + m * 16) * 256 + cw;
#pragma unroll
                    for (int bj = 0; bj < 2; ++bj) { *(f32x4*)(rowp + bj * HALF) = acc[ai][bj][m][0] * rs[ai][m]; *(f32x4*)(rowp + bj * HALF + 4) = acc[ai][bj][m][1] * rs[ai][m]; } }
        }
        else if (pn == 11) store_tile_bf16<0>(acc, QLAT, 256, row0, cw, rs);
        else if (pn < 16) store_tile_bf16<2>(acc, U, 1024, row0, (pn - 12) * 256 + cw, rs);
        else if (pn < 20) store_tile_bf16<2>(acc, V, 1024, row0, (pn - 16) * 256 + cw, rs);
        else store_tile_bf16<3>(acc, GATES, 3072, row0, (pn - 20) * 256 + cw, rs);
    }
};
struct EpiPlain {
    static constexpr bool PERM = true, AFTER_DRAIN = false;
    bf16_t* O; int ld;
    __device__ __forceinline__ void operator()(const f32x4 (&acc)[2][2][4][2], const Unit& u, int wr, int wc, int fr, int fq) const {
        float rs[2][4]; row_scales(nullptr, 0, rs); store_tile_bf16<0>(acc, O, ld, u.pm * BM + wr * 64 + fr, u.pn * BM + wc * 32 + 8 * fq, rs);
    }
};
__device__ __forceinline__ void gate_accumulate(const f32x4 (&acc)[2][2][4][2], bf16_t* MG, const bf16_t* GATES, int goff, int mode, int row0, int col0) {
#pragma unroll
    for (int ai = 0; ai < 2; ++ai)
#pragma unroll
        for (int m = 0; m < 4; ++m) { const size_t r = (size_t)(row0 + ai * HALF + m * 16);
#pragma unroll
            for (int bj = 0; bj < 2; ++bj) { const int c = col0 + bj * HALF;
                const u32x4 gw = *(const u32x4*)(GATES + r * 3072 + goff + c);
                f32x4 v0 = acc[ai][bj][m][0], v1 = acc[ai][bj][m][1];
                v0[0] *= bflo(gw.x); v0[1] *= bfhi(gw.x); v0[2] *= bflo(gw.y); v0[3] *= bfhi(gw.y);
                v1[0] *= bflo(gw.z); v1[1] *= bfhi(gw.z); v1[2] *= bflo(gw.w); v1[3] *= bfhi(gw.w);
                u32x4* dst = (u32x4*)(MG + r * 1024 + c);
                if (mode) { const u32x4 o = *dst;
                    v0[0] += bflo(o.x); v0[1] += bfhi(o.x); v0[2] += bflo(o.y); v0[3] += bfhi(o.y);
                    v1[0] += bflo(o.z); v1[1] += bfhi(o.z); v1[2] += bflo(o.w); v1[3] += bfhi(o.w); }
                u32x4 w; w.x = pkbf(v0[0], v0[1]); w.y = pkbf(v0[2], v0[3]); w.z = pkbf(v1[0], v1[1]); w.w = pkbf(v1[2], v1[3]);
                *dst = w; } }
}
struct EpiMix {
    static constexpr bool PERM = true, AFTER_DRAIN = false;
    bf16_t* MG; bf16_t* GATES; const float* ssq;
    __device__ __forceinline__ void operator()(const f32x4 (&acc)[2][2][4][2], const Unit& u, int wr, int wc, int fr, int fq) const {
        const int row0 = u.pm * BM + wr * 64 + fr, cw = wc * 32 + 8 * fq;
        if (u.pn < 12) { float rs[2][4]; row_scales(ssq, row0, rs); store_tile_bf16<3>(acc, GATES, 3072, row0, u.pn * 256 + cw, rs); }
        else { const int i = (u.pn - 12) >> 2, ct = (u.pn - 12) & 3; gate_accumulate(acc, MG, GATES, i * 1024, i, row0, ct * 256 + cw); }
    }
};
struct EpiResid {
    static constexpr bool PERM = true, AFTER_DRAIN = false;
    const float* base; float* out; bf16_t* xb; float* ssq;
    __device__ __forceinline__ void operator()(const f32x4 (&acc)[2][2][4][2], const Unit& u, int wr, int wc, int fr, int fq) const {
        const int row0 = u.pm * BM + wr * 64 + fr, col0 = u.pn * BM + wc * 32 + 8 * fq, lane = fr | (fq << 4);
#pragma unroll
        for (int ai = 0; ai < 2; ++ai)
#pragma unroll
            for (int m = 0; m < 4; ++m) { const size_t r = (size_t)(row0 + ai * HALF + m * 16); float sq = 0.f;
#pragma unroll
                for (int bj = 0; bj < 2; ++bj) { const size_t off = r * 1024 + col0 + bj * HALF;
                    const f32x4 v0 = *(const f32x4*)(base + off) + acc[ai][bj][m][0], v1 = *(const f32x4*)(base + off + 4) + acc[ai][bj][m][1];
                    *(f32x4*)(out + off) = v0; *(f32x4*)(out + off + 4) = v1;
                    if (xb) { u32x4 w; w.x = pkbf(v0[0], v0[1]); w.y = pkbf(v0[2], v0[3]); w.z = pkbf(v1[0], v1[1]); w.w = pkbf(v1[2], v1[3]); *(u32x4*)(xb + off) = w;
                        sq += (v0[0] * v0[0] + v0[1] * v0[1]) + (v0[2] * v0[2] + v0[3] * v0[3]) + (v1[0] * v1[0] + v1[1] * v1[1]) + (v1[2] * v1[2] + v1[3] * v1[3]); } }
                if (xb) { sq += __int_as_float(__builtin_amdgcn_ds_bpermute((lane ^ 16) << 2, __float_as_int(sq))); sq += __int_as_float(__builtin_amdgcn_ds_bpermute((lane ^ 32) << 2, __float_as_int(sq)));
                    if (fq == 0) ssq[r * 16 + u.pn * 4 + wc] = sq; } }
    }
};
struct EpiSwiglu {
    static constexpr bool PERM = true, AFTER_DRAIN = false;
    bf16_t* O; int ld; const float* ssq;
    __device__ __forceinline__ void operator()(const f32x4 (&acc)[2][2][4][2], const Unit& u, int wr, int wc, int fr, int fq) const {
        const int row0 = u.pm * BM + wr * 64 + fr, col0 = u.pn * HALF + wc * 32 + 8 * fq;
        float rs[2][4]; row_scales(ssq, row0, rs);
#pragma unroll
        for (int ai = 0; ai < 2; ++ai)
#pragma unroll
            for (int m = 0; m < 4; ++m) {
                const f32x4 g0 = act4<1>(acc[ai][0][m][0] * rs[ai][m]), g1 = act4<1>(acc[ai][0][m][1] * rs[ai][m]); const f32x4 v0 = g0 * (acc[ai][1][m][0] * rs[ai][m]), v1 = g1 * (acc[ai][1][m][1] * rs[ai][m]);
                u32x4 w; w.x = pkbf(v0[0], v0[1]); w.y = pkbf(v0[2], v0[3]); w.z = pkbf(v1[0], v1[1]); w.w = pkbf(v1[2], v1[3]);
                *(u32x4*)(O + (size_t)(row0 + ai * HALF + m * 16) * ld + col0) = w; }
    }
};
struct MixOrder {
    StaticOrder so; size_t aoff[3]; size_t boff;
    __device__ __forceinline__ bool next(int i, Unit& u) const { if (i >= 6) return false; Unit b; if (!so.next(0, b)) return false; u.pm = b.pm; u.pn = 4 * i + b.pn; return true; }
    __device__ __forceinline__ void a_ready(const Unit&) const {}
    __device__ __forceinline__ size_t a_off(const Unit& u) const { return u.pn < 12 ? (size_t)0 : (u.pn < 16 ? aoff[0] : (u.pn < 20 ? aoff[1] : aoff[2])); }
    __device__ __forceinline__ size_t b_off(const Unit& u) const { return u.pn < 12 ? (size_t)0 : boff; }
    __device__ __forceinline__ void done(const Unit&) const {}
};
struct MoeOrder {
    StaticOrder so; int toff[9]; size_t estride;
    __device__ __forceinline__ bool next(int i, Unit& u) const { return so.next(i, u); }
    __device__ __forceinline__ void a_ready(const Unit&) const {}
    __device__ __forceinline__ size_t a_off(const Unit&) const { return 0; }
    __device__ __forceinline__ size_t b_off(const Unit& u) const { int e = 0;
#pragma unroll
        for (int k = 1; k < 8; ++k) e += (u.pm >= toff[k]) ? 1 : 0;
        return (size_t)e * estride; }
    __device__ __forceinline__ void done(const Unit&) const {}
};

constexpr int TAIL_PIECES = 7, TAIL_ROWS = 8 * 256;
struct TailOrder {
    int ntail, c, toff[9]; size_t estride;
    __device__ __forceinline__ bool next(int i, Unit& u) const { if (i > 0) return false; const int t = c / TAIL_PIECES, piece = c % TAIL_PIECES; if (t >= ntail) return false; u.pm = 128 + (t >> 2); u.pn = (t & 3) + 4 * piece; return true; }
    __device__ __forceinline__ void a_ready(const Unit&) const {}
    __device__ __forceinline__ size_t a_off(const Unit& u) const { return (size_t)(u.pn >> 2) * 512 * 2; }
    __device__ __forceinline__ size_t b_off(const Unit& u) const { int e = 0;
#pragma unroll
        for (int k = 1; k < 8; ++k) e += (u.pm >= toff[k]) ? 1 : 0;
        const size_t piece = (size_t)(u.pn >> 2); return (size_t)e * estride + piece * 512 * 2 - piece * 4 * (size_t)(256 * 3584 * 2); }
    __device__ __forceinline__ void done(const Unit&) const {}
};
struct EpiTail {
    static constexpr bool PERM = true, AFTER_DRAIN = false;
    bf16_t* P;
    __device__ __forceinline__ void operator()(const f32x4 (&acc)[2][2][4][2], const Unit& u, int wr, int wc, int fr, int fq) const {
        float rs[2][4]; row_scales(nullptr, 0, rs);
        store_tile_bf16<0>(acc, P + (size_t)(u.pn >> 2) * TAIL_ROWS * 1024, 1024, (u.pm - 128) * BM + wr * 64 + fr, (u.pn & 3) * BM + wc * 32 + 8 * fq, rs);
    }
};
template <class Epi, class Sched, bool ALIGN_EPI = false, bool SP2 = false>
__device__ __forceinline__ void gemm_phase(PG8_LAS unsigned char* lds, const Gemm g, const Sched& S, const Epi& E) {
    int tid_ = threadIdx.x; asm volatile("" : "+v"(tid_));
    const int tid = tid_, wid = __builtin_amdgcn_readfirstlane(tid >> 6), lane = tid & 63, wr = wid >> 2, wc = wid & 3, fr = lane & 15, fq = lane >> 4;
    const int K = g.ld, nt = g.K / BK;
    unsigned voffA[2], voffB[2];
#pragma unroll
    for (int i = 0; i < 2; ++i) { int R, C; stage_rc(tid * 16 + i * 8192, R, C); const int Rb = Epi::PERM ? ((R & ~31) + perm32(R & 31)) : R;
        voffA[i] = (unsigned)(R * K + C) * 2u; voffB[i] = (unsigned)(Rb * K + C) * 2u; }
    const size_t kstep = (size_t)(BK * 2);
    const size_t hstep = (size_t)HALF * K * 2;
    const size_t tstep = 2 * hstep;
    const unsigned ldsw = (unsigned)wid * 1024u;
    const int aoff = lds_byte(wr * 64 + fr, fq * 8), boff = lds_byte(wc * 32 + fr, fq * 8);
#define PG8_SA(b, h) (((b) * 2 + (h)) * HTB)
#define PG8_SB(b, h) ((4 + (b) * 2 + (h)) * HTB)
#define PG8_STAGE(bufoff, gbase, voff) do { _Pragma("unroll") for (int _i = 0; _i < 2; ++_i) \
        __builtin_amdgcn_global_load_lds((const unsigned*)((const char*)(gbase) + (voff)[_i]), (PG8_LAS unsigned*)(lds + (bufoff) + ldsw + _i * 8192), 16, 0, 0); } while (0)
#define PG8_LDA(dst, b, h) do { _Pragma("unroll") for (int m = 0; m < 4; ++m) _Pragma("unroll") for (int k = 0; k < 2; ++k) dst[m][k] = *(const PG8_LAS bf16x8*)(lds + PG8_SA(b, h) + aoff + m * 2048 + k * 1024); } while (0)
#define PG8_LDB(dst, b, h) do { _Pragma("unroll") for (int n = 0; n < 2; ++n) _Pragma("unroll") for (int k = 0; k < 2; ++k) dst[n][k] = *(const PG8_LAS bf16x8*)(lds + PG8_SB(b, h) + boff + n * 2048 + k * 1024); } while (0)
#define PG8_MMA(ai, bj, At, Bt) do { __builtin_amdgcn_s_setprio(1); _Pragma("unroll") for (int m = 0; m < 4; ++m) _Pragma("unroll") for (int n = 0; n < 2; ++n) _Pragma("unroll") for (int k = 0; k < 2; ++k) \
        acc[ai][bj][m][n] = __builtin_amdgcn_mfma_f32_16x16x32_bf16(Bt[n][k], At[m][k], acc[ai][bj][m][n], 0, 0, 0); __builtin_amdgcn_s_setprio(0); } while (0)
#define PG8_WAIT_V(n) asm volatile("s_waitcnt vmcnt(" #n ")" ::: "memory")
#define PG8_WAIT_L(n) asm volatile("s_waitcnt lgkmcnt(" #n ")" ::: "memory")
#define PG8_BAR __builtin_amdgcn_s_barrier()
#define PG8_SCHED __builtin_amdgcn_sched_barrier(0)
    Unit cur, nxt; int ui = 0;
    if (!S.next(0, cur)) return;
    f32x4 acc[2][2][4][2];
#pragma unroll
    for (int a = 0; a < 2; ++a)
#pragma unroll
        for (int b = 0; b < 2; ++b)
#pragma unroll
            for (int m = 0; m < 4; ++m)
#pragma unroll
                for (int n = 0; n < 2; ++n) acc[a][b][m][n] = (f32x4){0.f, 0.f, 0.f, 0.f};
    bf16x8 At[4][2], B0[2][2], B1[2][2];
    const char* cA = (const char*)g.A + S.a_off(cur) + (size_t)cur.pm * tstep; const char* cB = (const char*)g.Bt + S.b_off(cur) + (size_t)cur.pn * tstep;
    S.a_ready(cur);
    if constexpr (SP2) {
        PG8_STAGE(PG8_SB(0, 0), cB, voffB); PG8_STAGE(PG8_SB(0, 1), cB + hstep, voffB); PG8_STAGE(PG8_SA(0, 0), cA, voffA); PG8_STAGE(PG8_SA(0, 1), cA + hstep, voffA);
        if (wr == 1) PG8_BAR;
        PG8_WAIT_V(2); PG8_BAR;
        PG8_STAGE(PG8_SB(1, 0), cB + kstep, voffB); PG8_STAGE(PG8_SA(1, 0), cA + kstep, voffA); PG8_STAGE(PG8_SB(1, 1), cB + hstep + kstep, voffB);
        PG8_WAIT_V(6); PG8_BAR;
    } else {
        PG8_STAGE(PG8_SB(0, 0), cB, voffB); PG8_STAGE(PG8_SA(0, 0), cA, voffA); PG8_STAGE(PG8_SB(0, 1), cB + hstep, voffB); PG8_STAGE(PG8_SA(0, 1), cA + hstep, voffA);
        if (wr == 1) PG8_BAR;
        PG8_WAIT_V(4); PG8_BAR;
        PG8_STAGE(PG8_SB(1, 0), cB + kstep, voffB); PG8_STAGE(PG8_SA(1, 0), cA + kstep, voffA); PG8_STAGE(PG8_SB(1, 1), cB + hstep + kstep, voffB);
        PG8_WAIT_V(6); PG8_BAR;
    }
    for (;;) {
        const bool has_next = S.next(ui + 1, nxt);
        const char* nA = has_next ? (const char*)g.A + S.a_off(nxt) + (size_t)nxt.pm * tstep : cA; const char* nB = has_next ? (const char*)g.Bt + S.b_off(nxt) + (size_t)nxt.pn * tstep : cB;
        for (int t = 0; t < nt; t += 2) {
            const bool last = (t == nt - 2);
            const char* a1 = cA + (size_t)(t + 1) * kstep;
            const char* a2 = last ? nA : cA + (size_t)(t + 2) * kstep; const char* b2 = last ? nB : cB + (size_t)(t + 2) * kstep;
            const char* a3 = a2 + kstep; const char* b3 = b2 + kstep;
            if (last && has_next) S.a_ready(nxt);
            if constexpr (SP2) {
            PG8_LDB(B0, 0, 0); PG8_LDB(B1, 0, 1); PG8_SCHED; PG8_LDA(At, 0, 0); PG8_STAGE(PG8_SA(1, 1), a1 + hstep, voffA);
            PG8_WAIT_V(8); PG8_WAIT_L(0); PG8_BAR; PG8_MMA(0, 0, At, B0); PG8_MMA(0, 1, At, B1); PG8_BAR; PG8_SCHED;
            PG8_LDA(At, 0, 1); PG8_STAGE(PG8_SB(0, 0), b2, voffB); PG8_STAGE(PG8_SB(0, 1), b2 + hstep, voffB); PG8_STAGE(PG8_SA(0, 0), a2, voffA);
            PG8_WAIT_V(8); PG8_WAIT_L(0); PG8_BAR; PG8_MMA(1, 0, At, B0); PG8_MMA(1, 1, At, B1); PG8_BAR; PG8_SCHED;
            PG8_LDB(B0, 1, 0); PG8_LDB(B1, 1, 1); PG8_SCHED; PG8_LDA(At, 1, 0); PG8_STAGE(PG8_SA(0, 1), a2 + hstep, voffA);
            PG8_WAIT_V(8); PG8_WAIT_L(0); PG8_BAR; PG8_MMA(0, 0, At, B0); PG8_MMA(0, 1, At, B1); PG8_BAR; PG8_SCHED;
            PG8_LDA(At, 1, 1); PG8_STAGE(PG8_SB(1, 0), b3, voffB); PG8_STAGE(PG8_SB(1, 1), b3 + hstep, voffB); PG8_STAGE(PG8_SA(1, 0), a3, voffA);
            PG8_WAIT_V(8); PG8_WAIT_L(0); PG8_BAR; PG8_MMA(1, 0, At, B0); PG8_MMA(1, 1, At, B1); PG8_BAR; PG8_SCHED;
            } else {
            PG8_LDB(B0, 0, 0); PG8_SCHED; PG8_LDA(At, 0, 0); PG8_STAGE(PG8_SA(1, 1), a1 + hstep, voffA);
            PG8_WAIT_L(8); PG8_BAR; PG8_WAIT_L(0); PG8_MMA(0, 0, At, B0); PG8_BAR; PG8_SCHED;
            PG8_LDB(B1, 0, 1); PG8_STAGE(PG8_SB(0, 0), b2, voffB);
            PG8_BAR; PG8_WAIT_L(0); PG8_MMA(0, 1, At, B1); PG8_BAR;
            PG8_LDA(At, 0, 1); PG8_STAGE(PG8_SA(0, 0), a2, voffA);
            PG8_BAR; PG8_WAIT_L(0); PG8_MMA(1, 0, At, B0); PG8_BAR; PG8_SCHED;
            PG8_STAGE(PG8_SB(0, 1), b2 + hstep, voffB);
            PG8_WAIT_V(6); PG8_BAR; PG8_MMA(1, 1, At, B1); PG8_BAR;
            PG8_LDB(B0, 1, 0); PG8_SCHED; PG8_LDA(At, 1, 0); PG8_STAGE(PG8_SA(0, 1), a2 + hstep, voffA);
            PG8_WAIT_L(8); PG8_BAR; PG8_WAIT_L(0); PG8_MMA(0, 0, At, B0); PG8_BAR; PG8_SCHED;
            PG8_LDB(B1, 1, 1); PG8_STAGE(PG8_SB(1, 0), b3, voffB);
            PG8_BAR; PG8_WAIT_L(0); PG8_MMA(0, 1, At, B1); PG8_BAR;
            PG8_LDA(At, 1, 1); PG8_STAGE(PG8_SA(1, 0), a3, voffA);
            PG8_BAR; PG8_WAIT_L(0); PG8_MMA(1, 0, At, B0); PG8_BAR; PG8_SCHED;
            PG8_STAGE(PG8_SB(1, 1), b3 + hstep, voffB);
            PG8_WAIT_V(6); PG8_BAR; PG8_MMA(1, 1, At, B1); PG8_BAR;
            }
        }
        if constexpr (ALIGN_EPI) { if (wr == 0) PG8_BAR; }
        if constexpr (!Epi::AFTER_DRAIN) { E(acc, cur, wr, wc, fr, fq); S.done(cur); }
        if (!has_next) break;
#pragma unroll
        for (int a = 0; a < 2; ++a)
#pragma unroll
            for (int b = 0; b < 2; ++b)
#pragma unroll
                for (int m = 0; m < 4; ++m)
#pragma unroll
                    for (int n = 0; n < 2; ++n) acc[a][b][m][n] = (f32x4){0.f, 0.f, 0.f, 0.f};
        cur = nxt; cA = nA; cB = nB; ++ui;
        if constexpr (ALIGN_EPI) { if (wr == 1) PG8_BAR; }
    }
    PG8_WAIT_V(0);
    if constexpr (!ALIGN_EPI) { if (wr == 0) PG8_BAR; }
    PG8_BAR;
    if constexpr (Epi::AFTER_DRAIN) { E.fused(acc, cur, wr, wc, fr, fq, lds, wid, lane); S.done(cur); }
#undef PG8_SA
#undef PG8_SB
#undef PG8_STAGE
#undef PG8_LDA
#undef PG8_LDB
#undef PG8_MMA
#undef PG8_WAIT_V
#undef PG8_WAIT_L
#undef PG8_BAR
#undef PG8_SCHED
}
}
#define GAS __attribute__((address_space(1)))
#define LAS __attribute__((address_space(3)))
typedef unsigned short bf16;
typedef unsigned v4u __attribute__((ext_vector_type(4)));
typedef float f32x4 __attribute__((ext_vector_type(4)));
typedef short bf16x8 __attribute__((ext_vector_type(8)));
typedef GAS unsigned gu32;
typedef GAS unsigned long long gu64;
#define RLX_AGENT __ATOMIC_RELAXED, __HIP_MEMORY_SCOPE_AGENT
#define LDS_WAIT() asm volatile("s_waitcnt lgkmcnt(0)" ::: "memory")
#define VM_WAIT() asm volatile("s_waitcnt vmcnt(0)" ::: "memory")
__device__ __forceinline__ unsigned long long rt() { return __builtin_amdgcn_s_memrealtime(); }
__device__ __forceinline__ unsigned f2bf(float f) { unsigned u = __builtin_bit_cast(unsigned, f); return (u + 0x7fffu + ((u >> 16) & 1u)) >> 16; }
__device__ __forceinline__ unsigned pk2(float lo, float hi) { return f2bf(lo) | (f2bf(hi) << 16); }

#define XB_TMO      128
#define XB_XCNT(j)  (256  + 64 * (j))
#define XB_XSUB(j)  (1280 + 64 * (j))
#define XB_XGEN(j)  (2304 + 64 * (j))
#define XB_TOP      3328
#define XB_TOPGEN   3392
#define XCD_BAR_WORDS 3456
#define XB_SPIN_CAP (1u << 18)

__device__ __forceinline__ unsigned xb_ld(unsigned* p)              { return __hip_atomic_load(p, __ATOMIC_RELAXED, __HIP_MEMORY_SCOPE_AGENT); }
__device__ __forceinline__ unsigned xb_add(unsigned* p, unsigned v) { return __hip_atomic_fetch_add(p, v, __ATOMIC_RELAXED, __HIP_MEMORY_SCOPE_AGENT); }
__device__ __forceinline__ unsigned xb_xcc_id() { return (unsigned)__builtin_amdgcn_s_getreg((3 << 11) | 20) & 0xFu; }
#define XB_SPIN(cond, bar) do { unsigned _sp = 0; while (cond) { __builtin_amdgcn_s_sleep(1); \
    if ((++_sp & 255u) == 0u) { if (xb_ld(&(bar)[XB_TMO])) break; if (_sp > XB_SPIN_CAP) { atomicAdd(&(bar)[XB_TMO], 1u); break; } } } } while (0)

struct XcdBarrier {
    unsigned* bar; unsigned x;
    volatile LAS unsigned* st;
};

__device__ __forceinline__ XcdBarrier xcd_barrier_post(unsigned* bar, volatile LAS unsigned* st) {
    XcdBarrier b; b.bar = bar; b.x = xb_xcc_id(); b.st = st;
    if (threadIdx.x == 0) (void)xb_add(&bar[XB_XCNT(b.x)], 1u);
    return b;
}
__device__ __forceinline__ void xcd_barrier_complete(unsigned* bar, unsigned x, unsigned& nloc, unsigned& nx) {
    const unsigned G = gridDim.x * gridDim.y * gridDim.z;
    unsigned sum, cnt, mine, sp = 0u;
    for (;;) {
        sum = 0u; cnt = 0u; mine = 0u;
#pragma unroll
        for (unsigned j = 0; j < 16; ++j) { const unsigned c = xb_ld(&bar[XB_XCNT(j)]); sum += c; cnt += (c > 0u) ? 1u : 0u; mine = (j == x) ? c : mine; }
        if (sum == G) break;
        __builtin_amdgcn_s_sleep(1);
        if ((++sp & 255u) == 0u) { if (xb_ld(&bar[XB_TMO])) break; if (sp > XB_SPIN_CAP) { atomicAdd(&bar[XB_TMO], 1u); break; } }
    }
    nloc = mine > 0u ? mine : 1u; nx = cnt > 0u ? cnt : 1u;
}

__device__ __forceinline__ void xcd_barrier(const XcdBarrier& b) {
    asm volatile("s_waitcnt vmcnt(0)" ::: "memory");
    __syncthreads();
    if (threadIdx.x == 0) {
        unsigned* bar = b.bar;
        __builtin_amdgcn_s_waitcnt(0);
        unsigned nloc = b.st[0], nx = b.st[1];
        if (nloc == 0u) { xcd_barrier_complete(bar, b.x, nloc, nx); b.st[0] = nloc; b.st[1] = nx; }
        const unsigned old = xb_add(&bar[XB_XSUB(b.x)], 1u);
        const unsigned gen = old / nloc;
        if (old + 1u == (gen + 1u) * nloc) {
            __builtin_amdgcn_fence(__ATOMIC_RELEASE, "agent");
            asm volatile("s_waitcnt vmcnt(0)" ::: "memory");
            const unsigned og = xb_add(&bar[XB_TOP], 1u);
            const unsigned tg = og / nx;
            if (og + 1u == (tg + 1u) * nx) xb_add(&bar[XB_TOPGEN], 1u);
            else XB_SPIN(xb_ld(&bar[XB_TOPGEN]) == tg, bar);
            __builtin_amdgcn_fence(__ATOMIC_ACQUIRE, "agent");
            xb_add(&bar[XB_XGEN(b.x)], 1u);
            asm volatile("s_waitcnt vmcnt(0)" ::: "memory");
        } else {
            XB_SPIN(xb_ld(&bar[XB_XGEN(b.x)]) == gen, bar);
            __builtin_amdgcn_fence(__ATOMIC_ACQUIRE, "agent");
            asm volatile("s_waitcnt vmcnt(0)" ::: "memory");
        }
    }
    __syncthreads();
}

constexpr int NTOK = 16384, SEQ = 4096, NBATCH = 4, DM = 1024, NWAVES = 8, NTHREADS = 512;
constexpr int NIN = 8112, NIN_PAD = 8192;
constexpr int FFD = 2816, FFE = 3584, NEXP = 8;
constexpr int MOE_ROWS_MAX = 2 * NTOK + NEXP * 256;
constexpr float RMS_EPS = 1e-6f, LN_EPS_C = 1e-5f;
constexpr float QSCALE = 0.10206207261596577f * 1.4426950408889634f;

constexpr size_t MiB = 1u << 20;
constexpr size_t WS_CTL = 0, CTL_ZERO_BYTES = 1 * MiB;
constexpr size_t WS_WL0 = 1 * MiB, WS_WL_STRIDE = 26 * MiB;
constexpr size_t WO_WIN = 0, WO_WUQ = 16 * MiB, WO_WUKV = 16 * MiB + 768 * 1024, WO_WBR = 17 * MiB + 256 * 1024, WO_WOUT = 23 * MiB + 256 * 1024;
constexpr size_t WS_WGU = 53 * MiB, WS_WDN = 64 * MiB, WS_ROPE = 69 * MiB + 512 * 1024;
constexpr size_t WS_H = 70 * MiB;
constexpr size_t WS_Z = 108 * MiB, WS_XBC = 140 * MiB, WS_MISC = 188 * MiB, WS_U = 204 * MiB, WS_V = 236 * MiB, WS_QRAW = 268 * MiB, WS_KVRAW = 316 * MiB,
                 WS_K = 380 * MiB, WS_VM = 428 * MiB, WS_STATES = 460 * MiB, WS_QLAT = 492 * MiB, WS_AQ = 500 * MiB, WS_AKV = 508 * MiB;
constexpr size_t WS_MERGED = WS_Z, WS_YSSD = WS_V, WS_O = WS_KVRAW, WS_GATES = WS_K;
constexpr size_t WS_TBL = 512 * MiB;
constexpr size_t WS_VSTAT = WS_TBL, WS_DTG = WS_TBL + 1 * MiB, WS_CSG = WS_TBL + 2 * MiB, WS_CDEC = WS_TBL + 3 * MiB, WS_RSTD = WS_TBL + 3 * MiB + 256 * 1024,
                 WS_TOKE = WS_TBL + 3 * MiB + 512 * 1024, WS_TOKP = WS_TBL + 3 * MiB + 768 * 1024, WS_TOKR = WS_TBL + 4 * MiB, WS_TOKW = WS_TBL + 4 * MiB + 256 * 1024, WS_SSQ = WS_TBL + 5 * MiB;
constexpr size_t WS_HID = 108 * MiB;
constexpr size_t WS_WMGU = 1 * MiB, WS_WMDN = 113 * MiB, WS_AG = 169 * MiB, WS_YP = WS_AG, WS_HIDM = 237 * MiB, WS_YPT = WS_WMGU;
constexpr size_t WS_END = 520 * MiB;
static_assert(WS_HIDM + (size_t)MOE_ROWS_MAX * FFE * 2 <= WS_TBL && WS_AG + (size_t)MOE_ROWS_MAX * DM * 2 <= WS_HIDM, "MoE overlay");
static_assert(WS_WL0 + 2 * WS_WL_STRIDE <= WS_WGU && WS_WDN + (size_t)DM * FFD * 2 <= WS_ROPE && WS_ROPE + 4096 * 16 * 8 <= WS_H, "weight map");
static_assert(WS_GATES + (size_t)NTOK * 3072 * 2 <= WS_QLAT && WS_AKV + (size_t)NTOK * 128 * 2 <= WS_TBL, "mixer map");
constexpr int CW_TMO = 0, CW_BAR = 4096, CW_CNT = 16384;

constexpr int LDS_BYTES = 147456;
constexpr int LDS_MISC_OFF = 131072 + 8192;

typedef unsigned u32x2 __attribute__((ext_vector_type(2)));
typedef float f32x16 __attribute__((ext_vector_type(16)));
typedef short s16x4 __attribute__((ext_vector_type(4)));
using pg8::pkbf; using pg8::bflo; using pg8::bfhi; using pg8::fsigmoid; using pg8::bf16_t; using pg8::u32x4;

struct Ctx {
    LAS unsigned char* lds; int lane, wave, vcu, G, bx;
    __device__ __forceinline__ int tid() const { return wave * 64 + lane; }
};
__device__ __forceinline__ float lane_xor(float v, int o, int lane) { return __int_as_float(__builtin_amdgcn_ds_bpermute((lane ^ o) << 2, __float_as_int(v))); }
__device__ __forceinline__ float lane_up(float v, int o, int lane) { return __int_as_float(__builtin_amdgcn_ds_bpermute((lane - o) << 2, __float_as_int(v))); }
__device__ __forceinline__ float wave_sum(float v, int lane) {
#pragma unroll
    for (int o = 1; o < 64; o <<= 1) v += lane_xor(v, o, lane);
    return v;
}
__device__ __forceinline__ int crow(int r, int hi) { return (r & 3) + 8 * (r >> 2) + 4 * hi; }
__device__ __forceinline__ s16x4 tr16(LAS const unsigned char* p) { typedef short v4i16_t __attribute__((ext_vector_type(4))); return __builtin_bit_cast(s16x4, __builtin_amdgcn_ds_read_tr16_b64_v4i16((LAS v4i16_t*)p)); }
__device__ __forceinline__ bf16x8 tr_frag(LAS const unsigned char* tile, int pitch, int kb, int c0, int lane) {
    const int g = lane >> 4, hi = g >> 1, q = (lane & 15) >> 2, p = lane & 3;
    LAS const unsigned char* a = tile + (kb + 8 * hi + q) * pitch + (c0 + 16 * (g & 1) + 4 * p) * 2;
    const s16x4 lo = tr16(a), h4 = tr16(a + 4 * pitch);
    return (bf16x8){lo[0], lo[1], lo[2], lo[3], h4[0], h4[1], h4[2], h4[3]};
}
__device__ __forceinline__ bf16x8 tr_frag_acc(LAS const unsigned char* tile, int pitch, int kb, int c0, int lane) {
    const int g = lane >> 4, hi = g >> 1, q = (lane & 15) >> 2, p = lane & 3;
    LAS const unsigned char* a = tile + (kb + 4 * hi + q) * pitch + (c0 + 16 * (g & 1) + 4 * p) * 2;
    const s16x4 lo = tr16(a), h4 = tr16(a + 8 * pitch);
    return (bf16x8){lo[0], lo[1], lo[2], lo[3], h4[0], h4[1], h4[2], h4[3]};
}
__device__ __forceinline__ bf16x8 row_frag(LAS const unsigned char* tile, int pitch, int r0, int kb, int lane) {
    return *(LAS const bf16x8*)(tile + (r0 + (lane & 31)) * pitch + (kb + 8 * (lane >> 5)) * 2);
}
#define MFMA32(a, b, c) __builtin_amdgcn_mfma_f32_32x32x16_bf16((a), (b), (c), 0, 0, 0)
__device__ __forceinline__ f32x16 zero16() { f32x16 z;
#pragma unroll
    for (int i = 0; i < 16; ++i) z[i] = 0.f;
    return z; }
__device__ __forceinline__ void unpack8(const u32x4 w, float (&f)[8]) { f[0] = bflo(w.x); f[1] = bfhi(w.x); f[2] = bflo(w.y); f[3] = bfhi(w.y); f[4] = bflo(w.z); f[5] = bfhi(w.z); f[6] = bflo(w.w); f[7] = bfhi(w.w); }
__device__ __forceinline__ u32x4 pack8(const float (&f)[8]) { u32x4 w; w.x = pkbf(f[0], f[1]); w.y = pkbf(f[2], f[3]); w.z = pkbf(f[4], f[5]); w.w = pkbf(f[6], f[7]); return w; }
__device__ __forceinline__ float silu_f(float x) { return x * fsigmoid(x); }

template <int KIND> __device__ __forceinline__ int wmap(int n) {
    if (KIND == 1) {
        if (n < 2560) return n;
        if (n < 2576) return 2720 + (n - 2560);
        if (n < 3600) return 3072 + (n - 2576);
        if (n < 4624) return 4096 + (n - 3600);
        if (n < 4880) return 2816 + (n - 4624);
        if (n < 5008) return 2560 + (n - 4880);
        if (n < 5040) return 2688 + (n - 5008);
        return 5120 + (n - 5040);
    }
    if (KIND == 2) return (n >> 7) * 256 + (n & 127);
    if (KIND == 3) return (n >> 7) * 256 + 128 + (n & 127);
    return n;
}
constexpr int TR_PITCH = 144, TR_WAVE_BYTES = 64 * TR_PITCH, TR_GROUP_BYTES = 256 * TR_PITCH;
template <int KIND> __device__ __forceinline__ void convert_matrix(const Ctx& F, const float* W, int K, int N, bf16_t* WT, const float* gain = nullptr) {
    LAS unsigned char* scr = F.lds + F.wave * TR_WAVE_BYTES;
    const int lane = F.lane, r = lane >> 4, cq = lane & 15, gw = F.vcu * NWAVES + F.wave, NGW = F.G * NWAVES, nblk = (N + 63) / 64, nitems = (K / 64) * nblk;
#define TR_LOAD(v, item) do { const int kb_ = (item) / nblk, nb_ = (item) % nblk, nc_ = (64 * nb_ + 4 * cq < N) ? 64 * nb_ + 4 * cq : N - 4;     \
        const float* src_ = W + (size_t)(64 * kb_ + 16 * r) * N + nc_; _Pragma("unroll") for (int i_ = 0; i_ < 16; ++i_) v[i_] = *(const f32x4*)(src_ + (size_t)i_ * N); } while (0)
#define TR_STORE(v, item) do { const int kb_ = (item) / nblk, nb_ = (item) % nblk, k0_ = 64 * kb_, n0_ = 64 * nb_; \
        if (gain) { _Pragma("unroll") for (int q_ = 0; q_ < 4; ++q_) { const f32x4 gq_ = *(const f32x4*)(gain + k0_ + 16 * r + 4 * q_); v[4 * q_] = v[4 * q_] * gq_.x; v[4 * q_ + 1] = v[4 * q_ + 1] * gq_.y; v[4 * q_ + 2] = v[4 * q_ + 2] * gq_.z; v[4 * q_ + 3] = v[4 * q_ + 3] * gq_.w; } } \
        _Pragma("unroll") for (int c_ = 0; c_ < 4; ++c_) { u32x4 lo_, hi_; lo_.x = pkbf(v[0][c_], v[1][c_]); lo_.y = pkbf(v[2][c_], v[3][c_]); lo_.z = pkbf(v[4][c_], v[5][c_]); lo_.w = pkbf(v[6][c_], v[7][c_]); \
            hi_.x = pkbf(v[8][c_], v[9][c_]); hi_.y = pkbf(v[10][c_], v[11][c_]); hi_.z = pkbf(v[12][c_], v[13][c_]); hi_.w = pkbf(v[14][c_], v[15][c_]); \
            *(LAS u32x4*)(scr + (4 * cq + c_) * TR_PITCH + 32 * r) = lo_; *(LAS u32x4*)(scr + (4 * cq + c_) * TR_PITCH + 32 * r + 16) = hi_; } \
        LDS_WAIT(); asm volatile("" ::: "memory"); \
        _Pragma("unroll") for (int j_ = 0; j_ < 8; ++j_) { const int n_ = 8 * j_ + (lane >> 3), c_ = lane & 7; const u32x4 o_ = *(LAS const u32x4*)(scr + n_ * TR_PITCH + 16 * c_); \
            if (n0_ + n_ < N) *(u32x4*)(WT + (size_t)wmap<KIND>(n0_ + n_) * K + k0_ + 8 * c_) = o_; } \
        LDS_WAIT(); asm volatile("" ::: "memory"); } while (0)
    int it = gw; if (it >= nitems) return;
    f32x4 va[16], vb[16];
    TR_LOAD(va, it);
#pragma unroll 1
    for (;;) {
        const int nx = it + NGW; const bool hn = nx < nitems;
        if (hn) TR_LOAD(vb, nx);
        TR_STORE(va, it);
        if (!hn) break;
        const int nx2 = nx + NGW; const bool hn2 = nx2 < nitems;
        if (hn2) TR_LOAD(va, nx2);
        TR_STORE(vb, nx);
        if (!hn2) break;
        it = nx2;
    }
#undef TR_LOAD
#undef TR_STORE
}

__device__ __forceinline__ void convert_moe(const Ctx& F, const float* Wg, const float* Wu, const float* Wd, bf16_t* WGU, bf16_t* WDN) {
    LAS unsigned char* scr = F.lds + F.wave * TR_WAVE_BYTES;
    const int lane = F.lane, r = lane >> 4, cq = lane & 15, gw = F.vcu * NWAVES + F.wave, NGW = F.G * NWAVES;
    constexpr int IPM = 896, NITEMS = 24 * IPM;
#define MOE_LOAD(v, item) do { const int mat_ = (item) / IPM, loc_ = (item) % IPM, e_ = mat_ / 3, ty_ = mat_ % 3; const int N_ = (ty_ == 2) ? DM : FFE, nblk_ = N_ / 64; \
        const float* W_ = ((ty_ == 0) ? Wg : (ty_ == 1) ? Wu : Wd) + (size_t)e_ * DM * FFE; const int kb_ = loc_ / nblk_, nb_ = loc_ % nblk_; \
        const float* src_ = W_ + (size_t)(64 * kb_ + 16 * r) * N_ + 64 * nb_ + 4 * cq; _Pragma("unroll") for (int i_ = 0; i_ < 16; ++i_) v[i_] = *(const f32x4*)(src_ + (size_t)i_ * N_); } while (0)
#define MOE_STORE(v, item) do { const int mat_ = (item) / IPM, loc_ = (item) % IPM, e_ = mat_ / 3, ty_ = mat_ % 3; const int N_ = (ty_ == 2) ? DM : FFE, K_ = (ty_ == 2) ? FFE : DM, nblk_ = N_ / 64; \
        const int kb_ = loc_ / nblk_, nb_ = loc_ % nblk_, k0_ = 64 * kb_, n0_ = 64 * nb_; \
        _Pragma("unroll") for (int c_ = 0; c_ < 4; ++c_) { u32x4 lo_, hi_; lo_.x = pkbf(v[0][c_], v[1][c_]); lo_.y = pkbf(v[2][c_], v[3][c_]); lo_.z = pkbf(v[4][c_], v[5][c_]); lo_.w = pkbf(v[6][c_], v[7][c_]); \
            hi_.x = pkbf(v[8][c_], v[9][c_]); hi_.y = pkbf(v[10][c_], v[11][c_]); hi_.z = pkbf(v[12][c_], v[13][c_]); hi_.w = pkbf(v[14][c_], v[15][c_]); \
            *(LAS u32x4*)(scr + (4 * cq + c_) * TR_PITCH + 32 * r) = lo_; *(LAS u32x4*)(scr + (4 * cq + c_) * TR_PITCH + 32 * r + 16) = hi_; } \
        LDS_WAIT(); asm volatile("" ::: "memory"); \
        bf16_t* D_ = (ty_ == 2) ? WDN + (size_t)e_ * DM * FFE : WGU + (size_t)e_ * 2 * FFE * DM; \
        _Pragma("unroll") for (int j_ = 0; j_ < 8; ++j_) { const int n_ = n0_ + 8 * j_ + (lane >> 3), c_ = lane & 7; const u32x4 o_ = *(LAS const u32x4*)(scr + (8 * j_ + (lane >> 3)) * TR_PITCH + 16 * c_); \
            const int row_ = (ty_ == 2) ? n_ : ((n_ >> 7) * 256 + (ty_ == 1 ? 128 : 0) + (n_ & 127)); \
            *(u32x4*)(D_ + (size_t)row_ * K_ + k0_ + 8 * c_) = o_; } \
        LDS_WAIT(); asm volatile("" ::: "memory"); } while (0)
    int it = gw; if (it >= NITEMS) return;
    f32x4 va[16], vb[16];
    MOE_LOAD(va, it);
#pragma unroll 1
    for (;;) {
        const int nx = it + NGW; { const int pf = nx < NITEMS ? nx : it; MOE_LOAD(vb, pf); }
        MOE_STORE(va, it);
        if (nx >= NITEMS) break;
        const int nx2 = nx + NGW; { const int pf = nx2 < NITEMS ? nx2 : nx; MOE_LOAD(va, pf); }
        MOE_STORE(vb, nx);
        if (nx2 >= NITEMS) break;
        it = nx2;
    }
#undef MOE_LOAD
#undef MOE_STORE
}

struct ConvJob { const float* src; bf16_t* dst; const float* gain; int K, N, kind, start; };
constexpr int CJ_MAX = 20, CJ_OFF = 8 * TR_WAVE_BYTES;
__device__ __forceinline__ void convert_jobs(const Ctx& F, int njobs) {
    LAS unsigned char* scr = F.lds + F.wave * TR_WAVE_BYTES; const LAS ConvJob* tab = (const LAS ConvJob*)(F.lds + CJ_OFF);
    const int lane = F.lane, r = lane >> 4, cq = lane & 15, gw = F.vcu * NWAVES + F.wave, NGW = F.G * NWAVES;
    const int nitems = __builtin_amdgcn_readfirstlane(tab[njobs].start);
#define CJ_FIND(item, jb, loc) int jb = 0; _Pragma("unroll 1") for (int q_ = 1; q_ < njobs; ++q_) { if (__builtin_amdgcn_readfirstlane(tab[q_].start) <= (item)) jb = q_; } const int loc = (item) - __builtin_amdgcn_readfirstlane(tab[jb].start)
#define CJ_LOAD(v, item) do { CJ_FIND(item, jb_, loc_); const int N_ = __builtin_amdgcn_readfirstlane(tab[jb_].N), nblk_ = (N_ + 63) / 64, kb_ = loc_ / nblk_, nb_ = loc_ % nblk_; \
        const GAS float* W_ = (const GAS float*)tab[jb_].src; const int nc_ = (64 * nb_ + 4 * cq < N_) ? 64 * nb_ + 4 * cq : N_ - 4; \
        const GAS float* src_ = W_ + (size_t)(64 * kb_ + 16 * r) * N_ + nc_; _Pragma("unroll") for (int i_ = 0; i_ < 16; ++i_) v[i_] = *(const GAS f32x4*)(src_ + (size_t)i_ * N_); } while (0)
#define CJ_STORE(v, item) do { CJ_FIND(item, jb_, loc_); const int N_ = __builtin_amdgcn_readfirstlane(tab[jb_].N), K_ = __builtin_amdgcn_readfirstlane(tab[jb_].K), kind_ = __builtin_amdgcn_readfirstlane(tab[jb_].kind); \
        const int nblk_ = (N_ + 63) / 64, kb_ = loc_ / nblk_, nb_ = loc_ % nblk_, k0_ = 64 * kb_, n0_ = 64 * nb_; const GAS float* gain_ = (const GAS float*)tab[jb_].gain; GAS bf16_t* D_ = (GAS bf16_t*)tab[jb_].dst; \
        if (gain_) { _Pragma("unroll") for (int q_ = 0; q_ < 4; ++q_) { const f32x4 gq_ = *(const GAS f32x4*)(gain_ + k0_ + 16 * r + 4 * q_); v[4 * q_] = v[4 * q_] * gq_.x; v[4 * q_ + 1] = v[4 * q_ + 1] * gq_.y; v[4 * q_ + 2] = v[4 * q_ + 2] * gq_.z; v[4 * q_ + 3] = v[4 * q_ + 3] * gq_.w; } } \
        _Pragma("unroll") for (int c_ = 0; c_ < 4; ++c_) { u32x4 lo_, hi_; lo_.x = pkbf(v[0][c_], v[1][c_]); lo_.y = pkbf(v[2][c_], v[3][c_]); lo_.z = pkbf(v[4][c_], v[5][c_]); lo_.w = pkbf(v[6][c_], v[7][c_]); \
            hi_.x = pkbf(v[8][c_], v[9][c_]); hi_.y = pkbf(v[10][c_], v[11][c_]); hi_.z = pkbf(v[12][c_], v[13][c_]); hi_.w = pkbf(v[14][c_], v[15][c_]); \
            *(LAS u32x4*)(scr + (4 * cq + c_) * TR_PITCH + 32 * r) = lo_; *(LAS u32x4*)(scr + (4 * cq + c_) * TR_PITCH + 32 * r + 16) = hi_; } \
        LDS_WAIT(); asm volatile("" ::: "memory"); \
        _Pragma("unroll") for (int j_ = 0; j_ < 8; ++j_) { const int n_ = n0_ + 8 * j_ + (lane >> 3), c_ = lane & 7; const u32x4 o_ = *(LAS const u32x4*)(scr + (8 * j_ + (lane >> 3)) * TR_PITCH + 16 * c_); \
            const int row_ = (kind_ == 1) ? wmap<1>(n_) : (kind_ == 2) ? wmap<2>(n_) : (kind_ == 3) ? wmap<3>(n_) : n_; \
            if (n_ < N_) *(GAS u32x4*)(D_ + (size_t)row_ * K_ + k0_ + 8 * c_) = o_; } \
        LDS_WAIT(); asm volatile("" ::: "memory"); } while (0)
    int it = gw; if (it >= nitems) return;
    f32x4 va[16], vb[16];
    CJ_LOAD(va, it);
#pragma unroll 1
    for (;;) {
        const int nx = it + NGW; { const int pf = nx < nitems ? nx : it; CJ_LOAD(vb, pf); }
        CJ_STORE(va, it);
        if (nx >= nitems) break;
        const int nx2 = nx + NGW; { const int pf = nx2 < nitems ? nx2 : nx; CJ_LOAD(va, pf); }
        CJ_STORE(vb, nx);
        if (nx2 >= nitems) break;
        it = nx2;
    }
#undef CJ_FIND
#undef CJ_LOAD
#undef CJ_STORE
}

template <int MODE> __device__ __forceinline__ void convert_probe(const Ctx& F, const float* W, int K, int N, bf16_t* WT) {
    const int grp = F.wave >> 2, j = F.wave & 3, lane = F.lane, gl = (F.wave & 3) * 64 + lane;
    LAS unsigned char* scr = F.lds + grp * TR_GROUP_BYTES;
    const int nblk = (N + 255) / 256, nitems = (K / 64) * nblk, NG = F.G * 2;
    const int iters = (nitems + NG - 1) / NG;
#pragma unroll 1
    for (int itn = 0; itn < iters; ++itn) {
        const int item = (F.vcu * 2 + grp) + itn * NG; const bool valid = item < nitems;
        const int kb = valid ? item / nblk : 0, nb = valid ? item % nblk : 0, k0 = 64 * kb, n0 = 256 * nb;
        if (valid && MODE != 3) {
            const int ncl = (n0 + 4 * lane < N) ? n0 + 4 * lane : N - 4;
            const float* src = W + (size_t)(k0 + 16 * j) * N + ncl;
            f32x4 v[16];
#pragma unroll
            for (int i = 0; i < 16; ++i) v[i] = *(const f32x4*)(src + (size_t)i * N);
            if (MODE == 2) {
#pragma unroll
                for (int i = 0; i < 16; ++i) asm volatile("" :: "v"(v[i]));
            } else {
#pragma unroll
            for (int c = 0; c < 4; ++c) {
                u32x4 lo, hi; lo.x = pkbf(v[0][c], v[1][c]); lo.y = pkbf(v[2][c], v[3][c]); lo.z = pkbf(v[4][c], v[5][c]); lo.w = pkbf(v[6][c], v[7][c]);
                hi.x = pkbf(v[8][c], v[9][c]); hi.y = pkbf(v[10][c], v[11][c]); hi.z = pkbf(v[12][c], v[13][c]); hi.w = pkbf(v[14][c], v[15][c]);
                *(LAS u32x4*)(scr + (4 * lane + c) * TR_PITCH + 32 * j) = lo; *(LAS u32x4*)(scr + (4 * lane + c) * TR_PITCH + 32 * j + 16) = hi;
            } }
        }
        __syncthreads();
        if (valid && MODE != 2) {
#pragma unroll
            for (int q = 0; q < 8; ++q) { const int n = 32 * q + (gl >> 3), c = gl & 7; const u32x4 o = *(LAS const u32x4*)(scr + n * TR_PITCH + 16 * c);
                if (MODE == 1) *(u32x4*)(WT + (size_t)item * 16384 + (size_t)(q * 256 + gl) * 8) = o;
                else if (n0 + n < N) *(u32x4*)(WT + (size_t)(n0 + n) * K + k0 + 8 * c) = o; }
        }
        __syncthreads();
    }
}

__device__ __forceinline__ void rmsnorm_rows(const Ctx& F, const float* x, const float* g, bf16_t* H) {
    const int gw = F.vcu * NWAVES + F.wave, NGW = F.G * NWAVES;
    f32x4 gv[4];
#pragma unroll
    for (int j = 0; j < 4; ++j) gv[j] = ((const f32x4*)g)[F.lane + 64 * j];
    f32x4 vn[4];
    if (gw < NTOK) { const f32x4* xr = (const f32x4*)(x + (size_t)gw * DM) + F.lane;
#pragma unroll
        for (int j = 0; j < 4; ++j) vn[j] = xr[64 * j]; }
#pragma unroll 1
    for (int m = gw; m < NTOK; m += NGW) {
        f32x4 v[4]; float s = 0.f;
#pragma unroll
        for (int j = 0; j < 4; ++j) { v[j] = vn[j]; s += (v[j].x * v[j].x + v[j].y * v[j].y) + (v[j].z * v[j].z + v[j].w * v[j].w); }
        { const int pf = (m + NGW < NTOK) ? m + NGW : m; const f32x4* xr = (const f32x4*)(x + (size_t)pf * DM) + F.lane;
#pragma unroll
          for (int j = 0; j < 4; ++j) vn[j] = xr[64 * j]; }
        const float rstd = 1.0f / sqrtf(wave_sum(s, F.lane) * (1.0f / DM) + RMS_EPS);
        u32x2* o = (u32x2*)(H + (size_t)m * DM) + F.lane;
#pragma unroll
        for (int j = 0; j < 4; ++j) { u32x2 w; w.x = pkbf(v[j].x * rstd * gv[j].x, v[j].y * rstd * gv[j].y); w.y = pkbf(v[j].z * rstd * gv[j].z, v[j].w * rstd * gv[j].w); o[64 * j] = w; }
    }
}
__device__ __forceinline__ void mixer_rowpass(const Ctx& F, const bf16_t* QLAT, const float* MISC, const bf16_t* V, const float* qg, const float* kvg, bf16_t* AQ, bf16_t* AKV, float* VSTAT) {
    const int gw = F.vcu * NWAVES + F.wave, NGW = F.G * NWAVES, lane = F.lane;
    const f32x4 gq = ((const f32x4*)qg)[lane]; const float gk0 = kvg[2 * lane], gk1 = kvg[2 * lane + 1];
#define RP_LOAD(Q_, A_, B_, W0_, W1_, m_) do { Q_ = ((const u32x2*)(QLAT + (size_t)(m_) * 256))[lane]; A_ = MISC[(size_t)(m_) * 256 + 2 * lane]; B_ = MISC[(size_t)(m_) * 256 + 2 * lane + 1]; \
        W0_ = ((const u32x4*)(V + (size_t)(m_) * 1024))[lane]; W1_ = ((const u32x4*)(V + (size_t)(m_) * 1024))[64 + lane]; } while (0)
#define RP_DO(Q_, A_, B_, W0_, W1_, m_) do { \
        { const float a = bflo(Q_.x), b = bfhi(Q_.x), c = bflo(Q_.y), d = bfhi(Q_.y); \
          const float rs = 1.0f / sqrtf(wave_sum((a * a + b * b) + (c * c + d * d), lane) * (1.0f / 256.0f) + RMS_EPS); \
          u32x2 o; o.x = pkbf(a * rs * gq.x, b * rs * gq.y); o.y = pkbf(c * rs * gq.z, d * rs * gq.w); ((u32x2*)(AQ + (size_t)(m_) * 256))[lane] = o; } \
        { const float rs = 1.0f / sqrtf(wave_sum(A_ * A_ + B_ * B_, lane) * (1.0f / 128.0f) + RMS_EPS); ((unsigned*)(AKV + (size_t)(m_) * 128))[lane] = pkbf(A_ * rs * gk0, B_ * rs * gk1); } \
        { float f[16]; { float t[8]; unpack8(W0_, t); _Pragma("unroll") for (int i = 0; i < 8; ++i) f[i] = t[i]; unpack8(W1_, t); _Pragma("unroll") for (int i = 0; i < 8; ++i) f[8 + i] = t[i]; } \
          float s = 0.f; _Pragma("unroll") for (int i = 0; i < 16; ++i) s += f[i]; \
          const float mean = wave_sum(s, lane) * (1.0f / 1024.0f); float q = 0.f; \
          _Pragma("unroll") for (int i = 0; i < 16; ++i) { const float d = f[i] - mean; q += d * d; } \
          const float rstd = 1.0f / sqrtf(wave_sum(q, lane) * (1.0f / 1024.0f) + LN_EPS_C); \
          if (lane == 0) { VSTAT[2 * (m_)] = mean; VSTAT[2 * (m_) + 1] = rstd; } } } while (0)
    int m = gw; if (m >= NTOK) return;
    u32x2 qa, qb; float aa, ab, ba, bb; u32x4 wa0, wa1, wb0, wb1;
    RP_LOAD(qa, aa, ab, wa0, wa1, m);
#pragma unroll 1
    for (;;) {
        const int n1 = m + NGW; { const int pf = n1 < NTOK ? n1 : m; RP_LOAD(qb, ba, bb, wb0, wb1, pf); }
        RP_DO(qa, aa, ab, wa0, wa1, m);
        if (n1 >= NTOK) break;
        const int n2 = n1 + NGW; { const int pf = n2 < NTOK ? n2 : n1; RP_LOAD(qa, aa, ab, wa0, wa1, pf); }
        RP_DO(qb, ba, bb, wb0, wb1, n1);
        if (n2 >= NTOK) break;
        m = n2;
    }
#undef RP_LOAD
#undef RP_DO
}
__device__ __forceinline__ void qk_finalize(const Ctx& F, bf16_t* QRAW, const bf16_t* KVRAW, const float* MISC, const float* qhg, const float* khg, const float* ROPE, bf16_t* Kout, bf16_t* Vout) {
    const int gw = F.vcu * NWAVES + F.wave, NGW = F.G * NWAVES, lane = F.lane, h = lane >> 2, j = lane & 3;
    float gqn[16], gkn[16], gq1[4], gq2[4], gk1[4], gk2[4];
#pragma unroll
    for (int i = 0; i < 16; ++i) { gqn[i] = qhg[16 * j + i]; gkn[i] = khg[16 * j + i]; }
#pragma unroll
    for (int i = 0; i < 4; ++i) { gq1[i] = qhg[64 + 4 * j + i]; gq2[i] = qhg[80 + 4 * j + i]; gk1[i] = khg[64 + 4 * j + i]; gk2[i] = khg[80 + 4 * j + i]; }
    struct Tok { u32x4 qn0, qn1, kn0, kn1, v0, v1; u32x2 q1, q2; f32x4 p1, p2, c0, c1; };
#define QK_LOAD(T_, m_) do { const bf16_t* qb_ = QRAW + (size_t)(m_) * 1536 + h * 96; const bf16_t* kvb_ = KVRAW + (size_t)(m_) * 2048 + h * 128; const int pos_ = (m_) & (SEQ - 1); \
        T_.qn0 = *(const u32x4*)(qb_ + 16 * j); T_.qn1 = *(const u32x4*)(qb_ + 16 * j + 8); T_.q1 = *(const u32x2*)(qb_ + 64 + 4 * j); T_.q2 = *(const u32x2*)(qb_ + 80 + 4 * j); \
        T_.kn0 = *(const u32x4*)(kvb_ + 16 * j); T_.kn1 = *(const u32x4*)(kvb_ + 16 * j + 8); T_.v0 = *(const u32x4*)(kvb_ + 64 + 16 * j); T_.v1 = *(const u32x4*)(kvb_ + 64 + 16 * j + 8); \
        T_.p1 = *(const f32x4*)(MISC + (size_t)(m_) * 256 + 128 + 4 * j); T_.p2 = *(const f32x4*)(MISC + (size_t)(m_) * 256 + 144 + 4 * j); \
        T_.c0 = *(const f32x4*)(ROPE + (size_t)pos_ * 32 + 8 * j); T_.c1 = *(const f32x4*)(ROPE + (size_t)pos_ * 32 + 8 * j + 4); } while (0)
#define QK_DO(T_, m_) do { \
        const float cc[4] = {T_.c0.x, T_.c0.z, T_.c1.x, T_.c1.z}, ss[4] = {T_.c0.y, T_.c0.w, T_.c1.y, T_.c1.w}; \
        {   bf16_t* qb = QRAW + (size_t)(m_) * 1536 + h * 96; \
            float n[16], x1[4], x2[4]; { float t[8]; unpack8(T_.qn0, t); _Pragma("unroll") for (int i = 0; i < 8; ++i) n[i] = t[i]; unpack8(T_.qn1, t); _Pragma("unroll") for (int i = 0; i < 8; ++i) n[8 + i] = t[i]; } \
            x1[0] = bflo(T_.q1.x); x1[1] = bfhi(T_.q1.x); x1[2] = bflo(T_.q1.y); x1[3] = bfhi(T_.q1.y); x2[0] = bflo(T_.q2.x); x2[1] = bfhi(T_.q2.x); x2[2] = bflo(T_.q2.y); x2[3] = bfhi(T_.q2.y); \
            float s = 0.f; _Pragma("unroll") for (int i = 0; i < 16; ++i) s += n[i] * n[i]; _Pragma("unroll") for (int i = 0; i < 4; ++i) s += x1[i] * x1[i] + x2[i] * x2[i]; \
            s += lane_xor(s, 1, lane); s += lane_xor(s, 2, lane); \
            const float rs = QSCALE / sqrtf(s * (1.0f / 96.0f) + RMS_EPS); \
            _Pragma("unroll") for (int i = 0; i < 16; ++i) n[i] *= rs * gqn[i]; \
            float o1[4], o2[4]; _Pragma("unroll") for (int i = 0; i < 4; ++i) { const float a = x1[i] * rs * gq1[i], b = x2[i] * rs * gq2[i]; o1[i] = a * cc[i] - b * ss[i]; o2[i] = a * ss[i] + b * cc[i]; } \
            { float t[8]; _Pragma("unroll") for (int i = 0; i < 8; ++i) t[i] = n[i]; *(u32x4*)(qb + 16 * j) = pack8(t); _Pragma("unroll") for (int i = 0; i < 8; ++i) t[i] = n[8 + i]; *(u32x4*)(qb + 16 * j + 8) = pack8(t); } \
            { u32x2 a, b; a.x = pkbf(o1[0], o1[1]); a.y = pkbf(o1[2], o1[3]); b.x = pkbf(o2[0], o2[1]); b.y = pkbf(o2[2], o2[3]); *(u32x2*)(qb + 64 + 4 * j) = a; *(u32x2*)(qb + 80 + 4 * j) = b; } } \
        {   float n[16], x1[4], x2[4]; { float t[8]; unpack8(T_.kn0, t); _Pragma("unroll") for (int i = 0; i < 8; ++i) n[i] = t[i]; unpack8(T_.kn1, t); _Pragma("unroll") for (int i = 0; i < 8; ++i) n[8 + i] = t[i]; } \
            x1[0] = T_.p1.x; x1[1] = T_.p1.y; x1[2] = T_.p1.z; x1[3] = T_.p1.w; x2[0] = T_.p2.x; x2[1] = T_.p2.y; x2[2] = T_.p2.z; x2[3] = T_.p2.w; \
            float s = 0.f; _Pragma("unroll") for (int i = 0; i < 16; ++i) s += n[i] * n[i]; _Pragma("unroll") for (int i = 0; i < 4; ++i) s += x1[i] * x1[i] + x2[i] * x2[i]; \
            s += lane_xor(s, 1, lane); s += lane_xor(s, 2, lane); \
            const float rs = 1.0f / sqrtf(s * (1.0f / 96.0f) + RMS_EPS); \
            _Pragma("unroll") for (int i = 0; i < 16; ++i) n[i] *= rs * gkn[i]; \
            float o1[4], o2[4]; _Pragma("unroll") for (int i = 0; i < 4; ++i) { const float a = x1[i] * rs * gk1[i], b = x2[i] * rs * gk2[i]; o1[i] = a * cc[i] - b * ss[i]; o2[i] = a * ss[i] + b * cc[i]; } \
            bf16_t* kb = Kout + (size_t)(m_) * 1536 + h * 96; \
            { float t[8]; _Pragma("unroll") for (int i = 0; i < 8; ++i) t[i] = n[i]; *(u32x4*)(kb + 16 * j) = pack8(t); _Pragma("unroll") for (int i = 0; i < 8; ++i) t[i] = n[8 + i]; *(u32x4*)(kb + 16 * j + 8) = pack8(t); } \
            { u32x2 a, b; a.x = pkbf(o1[0], o1[1]); a.y = pkbf(o1[2], o1[3]); b.x = pkbf(o2[0], o2[1]); b.y = pkbf(o2[2], o2[3]); *(u32x2*)(kb + 64 + 4 * j) = a; *(u32x2*)(kb + 80 + 4 * j) = b; } \
            bf16_t* vb = Vout + (size_t)(m_) * 1024 + h * 64 + 16 * j; *(u32x4*)vb = T_.v0; *(u32x4*)(vb + 8) = T_.v1; } } while (0)
    int m = gw; if (m >= NTOK) return;
    Tok ta, tb;
    QK_LOAD(ta, m);
#pragma unroll 1
    for (;;) {
        const int n1 = m + NGW; { const int pf = n1 < NTOK ? n1 : m; QK_LOAD(tb, pf); }
        QK_DO(ta, m);
        if (n1 >= NTOK) break;
        const int n2 = n1 + NGW; { const int pf = n2 < NTOK ? n2 : n1; QK_LOAD(ta, pf); }
        QK_DO(tb, n1);
        if (n2 >= NTOK) break;
        m = n2;
    }
#undef QK_LOAD
#undef QK_DO
}

template <int R> __device__ __forceinline__ void conv8(const bf16_t* xb, int s0, int ch0, const float* cw, const float* cb, float (&out)[R][8]) {
    float w[4][8], bias[8];
#pragma unroll
    for (int j = 0; j < 4; ++j) { const f32x4 a = *(const f32x4*)(cw + j * 1536 + ch0), b = *(const f32x4*)(cw + j * 1536 + ch0 + 4); w[j][0] = a.x; w[j][1] = a.y; w[j][2] = a.z; w[j][3] = a.w; w[j][4] = b.x; w[j][5] = b.y; w[j][6] = b.z; w[j][7] = b.w; }
    { const f32x4 a = *(const f32x4*)(cb + ch0), b = *(const f32x4*)(cb + ch0 + 4); bias[0] = a.x; bias[1] = a.y; bias[2] = a.z; bias[3] = a.w; bias[4] = b.x; bias[5] = b.y; bias[6] = b.z; bias[7] = b.w; }
    float x[R + 3][8];
#pragma unroll
    for (int i = 0; i < R + 3; ++i) { const int s = s0 - 3 + i; u32x4 raw = (u32x4){0u, 0u, 0u, 0u}; if (s >= 0) raw = *(const u32x4*)(xb + (size_t)s * 1536 + ch0); unpack8(raw, x[i]); }
#pragma unroll
    for (int r = 0; r < R; ++r)
#pragma unroll
        for (int e = 0; e < 8; ++e) { float a = bias[e];
#pragma unroll
            for (int j = 0; j < 4; ++j) a += w[j][e] * x[r + j][e];
            out[r][e] = silu_f(a); }
}
constexpr int SA_BS = 0, SA_XW = 40960, SA_CS = 65536, SA_DT = 69632;
constexpr int SC_CS_T = 0, SC_BM = 34816, SC_XS = 69632, SC_PV = 94208, SC_ZS = 111616, SC_CS = 130048, SC_DT = 134144, SC_SSQ = 138240;
__device__ __forceinline__ void ssd_pass_a(const Ctx& F, const bf16_t* XBC, const float* MISC, const float* conv_w, const float* conv_b, const float* dt_bias, const float* a_log,
                                           bf16_t* STATES, float* CSG, float* DTG, float* CDEC) {
    const int tid = F.tid(), lane = F.lane, w = F.wave, r32 = lane & 31, hi = lane >> 5;
    LAS unsigned char* Bs = F.lds + SA_BS; LAS unsigned char* Xw = F.lds + SA_XW; LAS float* csl = (LAS float*)(F.lds + SA_CS); LAS float* dtl = (LAS float*)(F.lds + SA_DT);
#pragma unroll 1
    for (int item = F.vcu; item < NBATCH * 32 * 2; item += F.G) {
        const int b = item >> 6, c = (item >> 1) & 31, g = item & 1;
        const bf16_t* xb = XBC + (size_t)b * SEQ * 1536; const int s_base = c * 128; const size_t tok0 = (size_t)b * SEQ + s_base;
        {
            const int cc = tid & 15, pr = tid >> 4; float o[4][8]; conv8<4>(xb, s_base + 4 * pr, 1024 + g * 128 + 8 * cc, conv_w, conv_b, o);
#pragma unroll
            for (int r = 0; r < 4; ++r) *(LAS u32x4*)(Bs + (4 * pr + r) * 320 + cc * 16) = pack8(o[r]);
        }
        {
            const int h = 8 * g + w; const float a = -__expf(a_log[h]), bias = dt_bias[h];
            float d0 = MISC[(tok0 + 2 * lane) * 256 + 160 + h] + bias, d1 = MISC[(tok0 + 2 * lane + 1) * 256 + 160 + h] + bias;
            d0 = d0 > 20.f ? d0 : __logf(1.0f + __expf(d0)); d1 = d1 > 20.f ? d1 : __logf(1.0f + __expf(d1));
            const float v0 = d0 * a, v1 = d1 * a; float inc = v0 + v1;
#pragma unroll
            for (int o = 1; o < 64; o <<= 1) { const float t = lane_up(inc, o, lane); if (lane >= o) inc += t; }
            const float c1 = inc, c0 = inc - v1;
            csl[w * 128 + 2 * lane] = c0; csl[w * 128 + 2 * lane + 1] = c1; dtl[w * 128 + 2 * lane] = d0; dtl[w * 128 + 2 * lane + 1] = d1;
            CSG[(tok0 + 2 * lane) * 16 + h] = c0; CSG[(tok0 + 2 * lane + 1) * 16 + h] = c1; DTG[(tok0 + 2 * lane) * 16 + h] = d0; DTG[(tok0 + 2 * lane + 1) * 16 + h] = d1;
            if (lane == 63) CDEC[(b * 32 + c) * 16 + h] = __expf(c1);
        }
        __syncthreads();
        const int cc = tid & 7, pr = tid >> 3;
        u32x4 rx[5];
#define PA_FETCH(hh_) do { _Pragma("unroll") for (int i_ = 0; i_ < 5; ++i_) { int s_ = s_base + 2 * pr - 3 + i_; s_ = s_ < 0 ? 0 : s_; rx[i_] = *(const u32x4*)(xb + (size_t)s_ * 1536 + 64 * (8 * g + (hh_)) + 8 * cc); } } while (0)
        PA_FETCH(0);
#pragma unroll 1
        for (int hh = 0; hh < 8; ++hh) {
            const int h = 8 * g + hh;
            {
                float o[2][8];
                { float wv[4][8], bias[8]; const int ch0 = 64 * h + 8 * cc;
#pragma unroll
                  for (int j = 0; j < 4; ++j) { const f32x4 wa = *(const f32x4*)(conv_w + j * 1536 + ch0), wb = *(const f32x4*)(conv_w + j * 1536 + ch0 + 4); wv[j][0] = wa.x; wv[j][1] = wa.y; wv[j][2] = wa.z; wv[j][3] = wa.w; wv[j][4] = wb.x; wv[j][5] = wb.y; wv[j][6] = wb.z; wv[j][7] = wb.w; }
                  { const f32x4 wa = *(const f32x4*)(conv_b + ch0), wb = *(const f32x4*)(conv_b + ch0 + 4); bias[0] = wa.x; bias[1] = wa.y; bias[2] = wa.z; bias[3] = wa.w; bias[4] = wb.x; bias[5] = wb.y; bias[6] = wb.z; bias[7] = wb.w; }
                  float xr[5][8];
#pragma unroll
                  for (int i = 0; i < 5; ++i) { u32x4 raw = rx[i]; if (s_base + 2 * pr - 3 + i < 0) raw = (u32x4){0u, 0u, 0u, 0u}; unpack8(raw, xr[i]); }
#pragma unroll
                  for (int r = 0; r < 2; ++r)
#pragma unroll
                      for (int e = 0; e < 8; ++e) { float acc = bias[e];
#pragma unroll
                          for (int j = 0; j < 4; ++j) acc += wv[j][e] * xr[r + j][e];
                          o[r][e] = silu_f(acc); } }
                const float ce = csl[hh * 128 + 127];
#pragma unroll
                for (int r = 0; r < 2; ++r) { const int l = 2 * pr + r; const float sc = dtl[hh * 128 + l] * __expf(ce - csl[hh * 128 + l]);
#pragma unroll
                    for (int e = 0; e < 8; ++e) o[r][e] *= sc;
                    *(LAS u32x4*)(Xw + l * 192 + cc * 16) = pack8(o[r]); }
            }
            __syncthreads();
            if (hh < 7) PA_FETCH(hh + 1);
            {   const int tp = w >> 2, tn = w & 3; f32x16 acc = zero16();
#pragma unroll
                for (int ks = 0; ks < 8; ++ks) acc = MFMA32(tr_frag(Xw, 192, 16 * ks, 32 * tp, lane), tr_frag(Bs, 320, 16 * ks, 32 * tn, lane), acc);
                bf16_t* st = STATES + ((size_t)((b * 32 + c) * 16 + h) * 64) * 128;
#pragma unroll
                for (int r = 0; r < 16; ++r) st[(size_t)(32 * tp + crow(r, hi)) * 128 + 32 * tn + r32] = (bf16_t)(pkbf(acc[r], 0.f) & 0xffffu);
            }
            __syncthreads();
        }
    }
}
#undef PA_FETCH
__device__ __forceinline__ void ssd_scan(const Ctx& F, bf16_t* STATES, const float* CDEC) {
    const int gt = F.vcu * NTHREADS + F.tid(), NGT = F.G * NTHREADS;
    for (int v = gt; v < NBATCH * 16 * 64 * 16; v += NGT) {
        const int bh = v >> 10, b = bh >> 4, h = bh & 15, rem = v & 1023;
        float carry[8];
#pragma unroll
        for (int i = 0; i < 8; ++i) carry[i] = 0.f;
        u32x4* p0 = (u32x4*)(STATES + ((size_t)(b * 32 * 16 + h) * 64) * 128 + (size_t)rem * 8);
        const float* d0 = CDEC + b * 32 * 16 + h;
#pragma unroll 1
        for (int c0 = 0; c0 < 32; c0 += 16) {
            u32x4 s[16]; float dec[16];
#pragma unroll
            for (int j = 0; j < 16; ++j) { s[j] = p0[(size_t)(c0 + j) * 16384]; dec[j] = d0[(c0 + j) * 16]; }
#pragma unroll
            for (int j = 0; j < 16; ++j) { float f[8]; unpack8(s[j], f); p0[(size_t)(c0 + j) * 16384] = pack8(carry);
#pragma unroll
                for (int i = 0; i < 8; ++i) carry[i] = carry[i] * dec[j] + f[i]; }
        }
    }
}
__device__ __forceinline__ void ssd_pass_c(const Ctx& F, const bf16_t* XBC, const bf16_t* STATES, const float* CSG, const float* DTG, const bf16_t* Z, const float* conv_w, const float* conv_b,
                                           const float* d_skip, const float* norm_g, bf16_t* YSSD) {
    const int tid = F.tid(), lane = F.lane, w = F.wave, r32 = lane & 31, hi = lane >> 5;
    LAS unsigned char* Cs = F.lds + SC_CS_T; LAS unsigned char* Bm = F.lds + SC_BM; LAS unsigned char* Xs = F.lds + SC_XS; LAS unsigned char* PVs = F.lds + SC_PV;
    LAS float* csl = (LAS float*)(F.lds + SC_CS); LAS float* dtl = (LAS float*)(F.lds + SC_DT); LAS float* ssql = (LAS float*)(F.lds + SC_SSQ); LAS unsigned char* Zs = F.lds + SC_ZS;
#pragma unroll 1
    for (int item = F.vcu; item < NBATCH * 32 * 2; item += F.G) {
        const int b = item >> 6, c = (item >> 1) & 31, g = item & 1;
        const bf16_t* xb = XBC + (size_t)b * SEQ * 1536; const int s_base = c * 128; const size_t tok0 = (size_t)b * SEQ + s_base;
        {   const int cc = tid & 15, pr = tid >> 4; float o[4][8];
            conv8<4>(xb, s_base + 4 * pr, 1280 + g * 128 + 8 * cc, conv_w, conv_b, o);
#pragma unroll
            for (int r = 0; r < 4; ++r) *(LAS u32x4*)(Cs + (4 * pr + r) * 272 + cc * 16) = pack8(o[r]);
            conv8<4>(xb, s_base + 4 * pr, 1024 + g * 128 + 8 * cc, conv_w, conv_b, o);
#pragma unroll
            for (int r = 0; r < 4; ++r) *(LAS u32x4*)(Bm + (4 * pr + r) * 272 + cc * 16) = pack8(o[r]);
        }
#pragma unroll
        for (int i = 0; i < 2; ++i) { const int id = tid + 512 * i, l = id >> 3, hh = id & 7; csl[hh * 128 + l] = CSG[(tok0 + l) * 16 + 8 * g + hh]; dtl[hh * 128 + l] = DTG[(tok0 + l) * 16 + 8 * g + hh]; }
        __syncthreads();
        const int tr = w >> 1, tc0 = 2 * (w & 1);
        f32x16 cb[2]; cb[0] = zero16(); cb[1] = zero16();
#pragma unroll
        for (int ks = 0; ks < 8; ++ks) { const bf16x8 a = row_frag(Cs, 272, 32 * tr, 16 * ks, lane);
            cb[0] = MFMA32(a, row_frag(Bm, 272, 32 * tc0, 16 * ks, lane), cb[0]); cb[1] = MFMA32(a, row_frag(Bm, 272, 32 * tc0 + 32, 16 * ks, lane), cb[1]); }
        __syncthreads();
        float ssq[16];
#pragma unroll
        for (int r = 0; r < 16; ++r) ssq[r] = 0.f;
        const int tp = w & 1;
#pragma unroll 1
        for (int hh = 0; hh < 8; ++hh) {
            const int h = 8 * g + hh;
            {   const int cc = tid & 7, pr = tid >> 3; float o[2][8]; conv8<2>(xb, s_base + 2 * pr, 64 * h + 8 * cc, conv_w, conv_b, o);
#pragma unroll
                for (int r = 0; r < 2; ++r) *(LAS u32x4*)(Xs + (2 * pr + r) * 192 + cc * 16) = pack8(o[r]);
                const bf16_t* st = STATES + ((size_t)((b * 32 + c) * 16 + h) * 64) * 128;
#pragma unroll
                for (int i = 0; i < 2; ++i) { const int id = tid + 512 * i, p = id >> 4, part = id & 15; *(LAS u32x4*)(PVs + p * 272 + part * 16) = *(const u32x4*)(st + (size_t)p * 128 + part * 8); }
#pragma unroll
                for (int i = 0; i < 2; ++i) { const int id = tid + 512 * i, l = id >> 3, part = id & 7; LAS u32x4* zp = (LAS u32x4*)(Zs + l * 144 + part * 16);
                    if (hh > 0) *(u32x4*)(YSSD + (tok0 + l) * 1024 + 64 * (h - 1) + 8 * part) = *zp;
                    *zp = *(const u32x4*)(Z + (tok0 + l) * 1024 + 64 * h + 8 * part); }
            }
#pragma unroll
            for (int j = 0; j < 2; ++j) { const int s = 32 * (tc0 + j) + r32; const float css = csl[hh * 128 + s], dts = dtl[hh * 128 + s];
#pragma unroll
                for (int r = 0; r < 16; ++r) { const int l = 32 * tr + crow(r, hi); const float v = (s <= l) ? cb[j][r] * __expf(csl[hh * 128 + l] - css) * dts : 0.f;
                    *(LAS bf16_t*)(Bm + l * 272 + s * 2) = (bf16_t)(pkbf(v, 0.f) & 0xffffu); } }
            __syncthreads();
            f32x16 a1 = zero16(), a2 = zero16();
#pragma unroll
            for (int ks = 0; ks < 8; ++ks) a1 = MFMA32(row_frag(Bm, 272, 32 * tr, 16 * ks, lane), tr_frag(Xs, 192, 16 * ks, 32 * tp, lane), a1);
#pragma unroll
            for (int ks = 0; ks < 8; ++ks) a2 = MFMA32(row_frag(Cs, 272, 32 * tr, 16 * ks, lane), row_frag(PVs, 272, 32 * tp, 16 * ks, lane), a2);
            const float dsk = d_skip[h]; const int p = 32 * tp + r32;
#pragma unroll
            for (int r = 0; r < 16; ++r) { const int l = 32 * tr + crow(r, hi);
                const float xv = __uint_as_float((unsigned)(*(LAS const bf16_t*)(Xs + l * 192 + p * 2)) << 16);
                const float y = a1[r] + __expf(csl[hh * 128 + l]) * a2[r] + dsk * xv;
                LAS bf16_t* zq = (LAS bf16_t*)(Zs + l * 144 + p * 2);
                const float yg = y * __uint_as_float((unsigned)(*zq) << 16);
                ssq[r] += yg * yg; *zq = (bf16_t)(pkbf(yg, 0.f) & 0xffffu); }
            __syncthreads();
        }
#pragma unroll
        for (int i = 0; i < 2; ++i) { const int id = tid + 512 * i, l = id >> 3, part = id & 7; *(u32x4*)(YSSD + (tok0 + l) * 1024 + 64 * (8 * g + 7) + 8 * part) = *(LAS const u32x4*)(Zs + l * 144 + part * 16); }
#pragma unroll
        for (int r = 0; r < 16; ++r) { float s = ssq[r]; s += lane_xor(s, 1, lane); s += lane_xor(s, 2, lane); s += lane_xor(s, 4, lane); s += lane_xor(s, 8, lane); s += lane_xor(s, 16, lane); if (r32 == 0) ssql[tp * 128 + 32 * tr + crow(r, hi)] = s; }
        __syncthreads();
#pragma unroll 1
        for (int hh = 0; hh < 8; ++hh) {
#pragma unroll
            for (int i = 0; i < 2; ++i) { const int id = tid + 512 * i, l = id >> 3, part = id & 7, ch = 64 * (8 * g + hh) + 8 * part;
                const float rs = 1.0f / sqrtf((ssql[l] + ssql[128 + l]) * (1.0f / 512.0f) + RMS_EPS);
                u32x4* yp = (u32x4*)(YSSD + (tok0 + l) * 1024 + ch); float f[8]; unpack8(*yp, f);
                const f32x4 g0 = *(const f32x4*)(norm_g + ch), g1 = *(const f32x4*)(norm_g + ch + 4);
                f[0] *= rs * g0.x; f[1] *= rs * g0.y; f[2] *= rs * g0.z; f[3] *= rs * g0.w; f[4] *= rs * g1.x; f[5] *= rs * g1.y; f[6] *= rs * g1.z; f[7] *= rs * g1.w;
                *yp = pack8(f); }
        }
        __syncthreads();
    }
}

constexpr int SG_W = 0, SG_V = 34816, SG_U = 75776;
__device__ __forceinline__ void sgu_phase(const Ctx& F, bf16_t* U, const bf16_t* V, const float* VSTAT, const float* ln_g, const float* ln_b, const float* sgu_w, const float* sgu_b) {
    const int tid = F.tid(), lane = F.lane, w = F.wave, r32 = lane & 31, hi = lane >> 5;
    LAS unsigned char* Ws = F.lds + SG_W; LAS unsigned char* Vn = F.lds + SG_V; LAS unsigned char* Us = F.lds + SG_U;
    int gcur = -1;
    u32x4 rv[4], ru[4]; float rm[4], rr[4];
#define SG_FETCH(item_) do { const int g_ = (item_) >> 7; const size_t t0_ = (size_t)((item_) & 127) * 128; \
        _Pragma("unroll") for (int i_ = 0; i_ < 4; ++i_) { const int id_ = tid + 512 * i_; const size_t tk_ = t0_ + (id_ >> 4); \
            rv[i_] = *(const u32x4*)(V + tk_ * 1024 + 128 * g_ + 8 * (id_ & 15)); ru[i_] = *(const u32x4*)(U + tk_ * 1024 + 128 * g_ + 8 * (id_ & 15)); rm[i_] = VSTAT[2 * tk_]; rr[i_] = VSTAT[2 * tk_ + 1]; } } while (0)
#pragma unroll 1
    for (int k = 0; k < 4; ++k) {
        const int item = F.vcu * 4 + k; if (item >= 1024) break;
        const int g = item >> 7, bc = item & 127; const size_t tok0 = (size_t)bc * 128;
        if (g != gcur) { gcur = g;
            const int t = tid >> 2, part = tid & 3; const float* src = sgu_w + ((size_t)g * 128 + t) * 128 + 32 * part;
#pragma unroll
            for (int q = 0; q < 4; ++q) { const f32x4 a = *(const f32x4*)(src + 8 * q), bb = *(const f32x4*)(src + 8 * q + 4); float f[8] = {a.x, a.y, a.z, a.w, bb.x, bb.y, bb.z, bb.w};
#pragma unroll
                for (int e = 0; e < 8; ++e) if (32 * part + 8 * q + e > t) f[e] = 0.f;
                *(LAS u32x4*)(Ws + t * 272 + (32 * part + 8 * q) * 2) = pack8(f); }
        }
        if (k == 0) SG_FETCH(item);
#pragma unroll
        for (int i = 0; i < 4; ++i) { const int id = tid + 512 * i, s = id >> 4, part = id & 15;
            float f[8]; unpack8(rv[i], f); const float mean = rm[i], rstd = rr[i];
            const f32x4 g0 = *(const f32x4*)(ln_g + 128 * g + 8 * part), g1 = *(const f32x4*)(ln_g + 128 * g + 8 * part + 4), b0 = *(const f32x4*)(ln_b + 128 * g + 8 * part), b1 = *(const f32x4*)(ln_b + 128 * g + 8 * part + 4);
            const float gg[8] = {g0.x, g0.y, g0.z, g0.w, g1.x, g1.y, g1.z, g1.w}, bb[8] = {b0.x, b0.y, b0.z, b0.w, b1.x, b1.y, b1.z, b1.w};
#pragma unroll
            for (int e = 0; e < 8; ++e) f[e] = (f[e] - mean) * rstd * gg[e] + bb[e];
            *(LAS u32x4*)(Vn + s * 320 + part * 16) = pack8(f);
            *(LAS u32x4*)(Us + s * 272 + part * 16) = ru[i]; }
        __syncthreads();
        if (k < 3 && item + 1 < 1024) SG_FETCH(item + 1);
        const int tr = w >> 1, tc0 = 2 * (w & 1);
        f32x16 acc[2]; acc[0] = zero16(); acc[1] = zero16();
#pragma unroll
        for (int ks = 0; ks < 8; ++ks) { const bf16x8 a = row_frag(Ws, 272, 32 * tr, 16 * ks, lane);
            acc[0] = MFMA32(a, tr_frag(Vn, 320, 16 * ks, 32 * tc0, lane), acc[0]); acc[1] = MFMA32(a, tr_frag(Vn, 320, 16 * ks, 32 * tc0 + 32, lane), acc[1]); }
#pragma unroll
        for (int j = 0; j < 2; ++j)
#pragma unroll
            for (int r = 0; r < 16; ++r) { const int t = 32 * tr + crow(r, hi); LAS bf16_t* up = (LAS bf16_t*)(Us + t * 272 + (32 * (tc0 + j) + r32) * 2);
                const float y = __uint_as_float((unsigned)(*up) << 16) * (acc[j][r] + sgu_b[g * 128 + t]); *up = (bf16_t)(pkbf(y, 0.f) & 0xffffu); }
        __syncthreads();
#pragma unroll
        for (int i = 0; i < 4; ++i) { const int id = tid + 512 * i, s = id >> 4, part = id & 15;
            *(u32x4*)(U + (tok0 + s) * 1024 + 128 * g + 8 * part) = *(LAS const u32x4*)(Us + s * 272 + part * 16); }
    }
#undef SG_FETCH
}


constexpr int AT_K = 0, AT_KB = 13312, AT_V = 26624, AT_VB = 12288, AT_O = 63488;
__device__ __forceinline__ void attn_unit(const Ctx& F, int b, int h, int qb, const bf16_t* Q, const bf16_t* K, const bf16_t* V, bf16_t* O) {
    const int tid = F.tid(), lane = F.lane, w = F.wave, r32 = lane & 31, hi = lane >> 5;
    const size_t tok0 = (size_t)b * SEQ; const int q0 = qb * 256 + w * 32, NT = 4 * qb + 4;
    bf16x8 qf[6];
#pragma unroll
    for (int ks = 0; ks < 6; ++ks) qf[ks] = *(const bf16x8*)(Q + ((tok0 + q0 + r32) * 16 + h) * 96 + 16 * ks + 8 * hi);
    const int kk0 = tid / 12, kp0 = tid % 12, kk1 = (tid + 512) / 12, kp1 = (tid + 512) % 12, vk = tid >> 3, vp = tid & 7;
    const bf16_t* kg0 = K + ((tok0 + kk0) * 16 + h) * 96 + kp0 * 8; const bf16_t* kg1 = K + ((tok0 + kk1) * 16 + h) * 96 + kp1 * 8; const bf16_t* vg = V + ((tok0 + vk) * 16 + h) * 64 + vp * 8;
    const int kl0 = kk0 * 208 + kp0 * 16, kl1 = kk1 * 208 + kp1 * 16, vl = vk * 192 + vp * 16;
    const size_t tstepK = (size_t)64 * 16 * 96, tstepV = (size_t)64 * 16 * 64;
    u32x4 ak0, ak1 = (u32x4){0u, 0u, 0u, 0u}, av, bk0, bk1 = (u32x4){0u, 0u, 0u, 0u}, bv;
    ak0 = *(const u32x4*)kg0; if (tid < 256) ak1 = *(const u32x4*)kg1; av = *(const u32x4*)vg;
    *(LAS u32x4*)(F.lds + AT_K + kl0) = ak0; if (tid < 256) *(LAS u32x4*)(F.lds + AT_K + kl1) = ak1; *(LAS u32x4*)(F.lds + AT_V + vl) = av;
    ak0 = *(const u32x4*)(kg0 + tstepK); if (tid < 256) ak1 = *(const u32x4*)(kg1 + tstepK); av = *(const u32x4*)(vg + tstepV);
    __syncthreads();
    float l_run = 0.f; f32x16 o0 = zero16(), o1 = zero16();
    const bool lag = w >= 4; bool pend = false;
    bf16x8 pb[4];
#define AT_PV(Vb_) do { _Pragma("unroll") for (int s_ = 0; s_ < 2; ++s_) { \
        o0 = MFMA32(tr_frag_acc(Vb_, 192, 16 * s_, 0, lane), pb[s_], o0);           o1 = MFMA32(tr_frag_acc(Vb_, 192, 16 * s_, 32, lane), pb[s_], o1); \
        o0 = MFMA32(tr_frag_acc(Vb_, 192, 32 + 16 * s_, 0, lane), pb[2 + s_], o0);  o1 = MFMA32(tr_frag_acc(Vb_, 192, 32 + 16 * s_, 32, lane), pb[2 + s_], o1); } } while (0)
    int vcur = 0, vprev = 2;
#define AT_STEP(t, LK0, LK1, LV, WK0, WK1, WV) do { \
        const int cur = (t) & 1, vnext = 3 - vcur - vprev; \
        if ((t) + 2 < NT) { LK0 = *(const u32x4*)(kg0 + (size_t)((t) + 2) * tstepK); if (tid < 256) LK1 = *(const u32x4*)(kg1 + (size_t)((t) + 2) * tstepK); LV = *(const u32x4*)(vg + (size_t)((t) + 2) * tstepV); } \
        if (pend) { LAS const unsigned char* Vp = F.lds + AT_V + vprev * AT_VB; AT_PV(Vp); pend = false; } \
        if (64 * (t) <= q0 + 31) { \
            LAS const unsigned char* Kb = F.lds + AT_K + cur * AT_KB; LAS const unsigned char* Vb = F.lds + AT_V + vcur * AT_VB; \
            f32x16 p0 = MFMA32(row_frag(Kb, 208, 0, 0, lane), qf[0], zero16()), p1 = MFMA32(row_frag(Kb, 208, 32, 0, lane), qf[0], zero16()); \
            _Pragma("unroll") for (int ks = 1; ks < 6; ++ks) { p0 = MFMA32(row_frag(Kb, 208, 0, 16 * ks, lane), qf[ks], p0); p1 = MFMA32(row_frag(Kb, 208, 32, 16 * ks, lane), qf[ks], p1); } \
            if (64 * (t) + 63 > q0) { const int qa = q0 + r32; \
                _Pragma("unroll") for (int r = 0; r < 16; ++r) { const int ka = 64 * (t) + crow(r, hi); if (ka > qa) p0[r] = -INFINITY; if (ka + 32 > qa) p1[r] = -INFINITY; } } \
            float sum = 0.f; \
            _Pragma("unroll") for (int r = 0; r < 16; ++r) { p0[r] = __builtin_amdgcn_exp2f(p0[r]); p1[r] = __builtin_amdgcn_exp2f(p1[r]); sum += p0[r] + p1[r]; } \
            l_run += sum; \
            _Pragma("unroll") for (int s = 0; s < 2; ++s) { \
                { u32x4 x; x.x = pkbf(p0[8 * s + 0], p0[8 * s + 1]); x.y = pkbf(p0[8 * s + 2], p0[8 * s + 3]); x.z = pkbf(p0[8 * s + 4], p0[8 * s + 5]); x.w = pkbf(p0[8 * s + 6], p0[8 * s + 7]); pb[s] = __builtin_bit_cast(bf16x8, x); } \
                { u32x4 x; x.x = pkbf(p1[8 * s + 0], p1[8 * s + 1]); x.y = pkbf(p1[8 * s + 2], p1[8 * s + 3]); x.z = pkbf(p1[8 * s + 4], p1[8 * s + 5]); x.w = pkbf(p1[8 * s + 6], p1[8 * s + 7]); pb[2 + s] = __builtin_bit_cast(bf16x8, x); } } \
            if (lag) pend = true; else AT_PV(Vb); \
        } \
        if ((t) + 1 < NT) { const int nx = cur ^ 1; *(LAS u32x4*)(F.lds + AT_K + nx * AT_KB + kl0) = WK0; if (tid < 256) *(LAS u32x4*)(F.lds + AT_K + nx * AT_KB + kl1) = WK1; *(LAS u32x4*)(F.lds + AT_V + vnext * AT_VB + vl) = WV; } \
        __syncthreads(); \
        vprev = vcur; vcur = vnext; } while (0)
#pragma unroll 1
    for (int t = 0; t < NT; t += 2) { AT_STEP(t, bk0, bk1, bv, ak0, ak1, av); AT_STEP(t + 1, ak0, ak1, av, bk0, bk1, bv); }
#undef AT_STEP
    if (pend) { LAS const unsigned char* Vp = F.lds + AT_V + vprev * AT_VB; AT_PV(Vp); }
#undef AT_PV
    l_run += lane_xor(l_run, 32, lane);
    const float inv = 1.0f / l_run;
    LAS bf16_t* stg = (LAS bf16_t*)(F.lds + AT_O + w * 4096);
#pragma unroll
    for (int r = 0; r < 16; ++r) { const int d = crow(r, hi); stg[r32 * 64 + d] = (bf16_t)(pkbf(o0[r] * inv, 0.f) & 0xffffu); stg[r32 * 64 + 32 + d] = (bf16_t)(pkbf(o1[r] * inv, 0.f) & 0xffffu); }
    LDS_WAIT(); asm volatile("" ::: "memory");
#pragma unroll
    for (int i = 0; i < 4; ++i) { const int row = i * 8 + (lane >> 3), ch = lane & 7; *(u32x4*)(O + ((tok0 + q0 + row) * 16 + h) * 64 + ch * 8) = *(LAS const u32x4*)(stg + row * 64 + ch * 8); }
    __syncthreads();
}
__device__ __forceinline__ void attn_phase(const Ctx& F, const bf16_t* Q, const bf16_t* K, const bf16_t* V, bf16_t* O, const float* qhg, const float* khg) {
    const int bh = F.vcu >> 2, s = F.vcu & 3;
    if (bh >= NBATCH * 16) return;
#pragma unroll 1
    for (int i = 0; i < 4; ++i) { const int qb = (i == 0) ? s : (i == 1) ? 7 - s : (i == 2) ? 8 + s : 15 - s; attn_unit(F, bh >> 4, bh & 15, qb, Q, K, V, O); }
}

__device__ __forceinline__ void moe_route(const Ctx& F, const float* x, const float* g, const float* Wr, unsigned* CNT, float* RSTD, int* TOKE, int* TOKP, float* TOKW) {
    const int gw = F.vcu * NWAVES + F.wave, NGW = F.G * NWAVES, lane = F.lane;
    f32x4 gv[4];
#pragma unroll
    for (int j = 0; j < 4; ++j) gv[j] = ((const f32x4*)g)[lane + 64 * j];
    f32x4 wreg[4][4][2];
#pragma unroll
    for (int j = 0; j < 4; ++j)
#pragma unroll
        for (int i = 0; i < 4; ++i) { const float* wr = Wr + (size_t)(4 * (lane + 64 * j) + i) * 8; wreg[j][i][0] = *(const f32x4*)wr; wreg[j][i][1] = *(const f32x4*)(wr + 4); }
    f32x4 vn[4];
    if (gw < NTOK) { const f32x4* xr = (const f32x4*)(x + (size_t)gw * DM) + lane;
#pragma unroll
        for (int j = 0; j < 4; ++j) vn[j] = xr[64 * j]; }
#pragma unroll 1
    for (int m = gw; m < NTOK; m += NGW) {
        f32x4 v[4]; float s = 0.f;
#pragma unroll
        for (int j = 0; j < 4; ++j) { v[j] = vn[j]; s += (v[j].x * v[j].x + v[j].y * v[j].y) + (v[j].z * v[j].z + v[j].w * v[j].w); }
        { const int pf = (m + NGW < NTOK) ? m + NGW : m; const f32x4* xr = (const f32x4*)(x + (size_t)pf * DM) + lane;
#pragma unroll
          for (int j = 0; j < 4; ++j) vn[j] = xr[64 * j]; }
        const float rstd = 1.0f / sqrtf(wave_sum(s, lane) * (1.0f / DM) + RMS_EPS);
        float lg[8];
#pragma unroll
        for (int e = 0; e < 8; ++e) lg[e] = 0.f;
#pragma unroll
        for (int j = 0; j < 4; ++j) { const float hv[4] = {v[j].x * rstd * gv[j].x, v[j].y * rstd * gv[j].y, v[j].z * rstd * gv[j].z, v[j].w * rstd * gv[j].w};
#pragma unroll
            for (int i = 0; i < 4; ++i) { const f32x4 a = wreg[j][i][0], bq = wreg[j][i][1];
                lg[0] += hv[i] * a.x; lg[1] += hv[i] * a.y; lg[2] += hv[i] * a.z; lg[3] += hv[i] * a.w; lg[4] += hv[i] * bq.x; lg[5] += hv[i] * bq.y; lg[6] += hv[i] * bq.z; lg[7] += hv[i] * bq.w; } }
#pragma unroll
        for (int e = 0; e < 8; ++e) lg[e] = wave_sum(lg[e], lane);
        int i0 = 0; float v0 = lg[0];
#pragma unroll
        for (int e = 1; e < 8; ++e) if (lg[e] > v0) { v0 = lg[e]; i0 = e; }
        int i1 = -1; float v1 = -INFINITY;
#pragma unroll
        for (int e = 0; e < 8; ++e) if (e != i0 && lg[e] > v1) { v1 = lg[e]; i1 = e; }
        if (lane == 0) {
            const float w0 = 1.0f / (1.0f + __expf(v1 - v0));
            const unsigned p0 = atomicAdd(CNT + 64 * i0, 1u), p1 = atomicAdd(CNT + 64 * i1, 1u);
            RSTD[m] = rstd; TOKE[2 * m] = i0; TOKE[2 * m + 1] = i1; TOKP[2 * m] = (int)p0; TOKP[2 * m + 1] = (int)p1; TOKW[2 * m] = w0; TOKW[2 * m + 1] = 1.0f - w0;
        }
    }
}
__device__ __forceinline__ void moe_offsets(const unsigned* CNT, int (&off)[9]) {
    off[0] = 0;
#pragma unroll
    for (int e = 0; e < 8; ++e) { const unsigned c = __hip_atomic_load(CNT + 64 * e, __ATOMIC_RELAXED, __HIP_MEMORY_SCOPE_AGENT); off[e + 1] = off[e] + __builtin_amdgcn_readfirstlane((int)((c + 255u) & ~255u)); }
}
__device__ __forceinline__ void moe_scatter(const Ctx& F, const float* x, const float* g, const unsigned* CNT, const float* RSTD, const int* TOKE, const int* TOKP, int* TOKR, bf16_t* AG) {
    const int gw = F.vcu * NWAVES + F.wave, NGW = F.G * NWAVES, lane = F.lane;
    int off[9]; moe_offsets(CNT, off);
    f32x4 gv[4];
#pragma unroll
    for (int j = 0; j < 4; ++j) gv[j] = ((const f32x4*)g)[lane + 64 * j];
    struct Tok { f32x4 v[4]; float rstd; int e0, e1, p0, p1; };
#define SC_LOAD(T_, m_) do { const f32x4* xr_ = (const f32x4*)(x + (size_t)(m_) * DM) + lane; _Pragma("unroll") for (int j_ = 0; j_ < 4; ++j_) T_.v[j_] = xr_[64 * j_]; \
        T_.rstd = RSTD[m_]; T_.e0 = TOKE[2 * (m_)]; T_.e1 = TOKE[2 * (m_) + 1]; T_.p0 = TOKP[2 * (m_)]; T_.p1 = TOKP[2 * (m_) + 1]; } while (0)
#define SC_DO(T_, m_) do { int r0 = T_.p0, r1 = T_.p1; _Pragma("unroll") for (int e_ = 0; e_ < 8; ++e_) { if (e_ == T_.e0) r0 += off[e_]; if (e_ == T_.e1) r1 += off[e_]; } \
        if (lane == 0) { TOKR[2 * (m_)] = r0; TOKR[2 * (m_) + 1] = r1; } \
        u32x2* o0 = (u32x2*)(AG + (size_t)r0 * DM) + lane; u32x2* o1 = (u32x2*)(AG + (size_t)r1 * DM) + lane; const float rstd = T_.rstd; \
        _Pragma("unroll") for (int j = 0; j < 4; ++j) { const f32x4 v = T_.v[j]; u32x2 wv; wv.x = pkbf(v.x * rstd * gv[j].x, v.y * rstd * gv[j].y); wv.y = pkbf(v.z * rstd * gv[j].z, v.w * rstd * gv[j].w); o0[64 * j] = wv; o1[64 * j] = wv; } } while (0)
    int m = gw; if (m >= NTOK) return;
    Tok ta, tb;
    SC_LOAD(ta, m);
#pragma unroll 1
    for (;;) {
        const int n1 = m + NGW; { const int pf = n1 < NTOK ? n1 : m; SC_LOAD(tb, pf); }
        SC_DO(ta, m);
        if (n1 >= NTOK) break;
        const int n2 = n1 + NGW; { const int pf = n2 < NTOK ? n2 : n1; SC_LOAD(ta, pf); }
        SC_DO(tb, n1);
        if (n2 >= NTOK) break;
        m = n2;
    }
#undef SC_LOAD
#undef SC_DO
}
__device__ __forceinline__ void moe_combine(const Ctx& F, float* x, const bf16_t* YP, const bf16_t* YPT, const int* TOKR, const float* TOKW) {
    const int gw = F.vcu * NWAVES + F.wave, NGW = F.G * NWAVES, lane = F.lane;
    struct Tok { f32x4 v[4]; u32x2 y0[4], y1[4]; float w0, w1; int r0, r1; };
#define CB_LD1(T_, m_) do { const f32x4* xr_ = (const f32x4*)(x + (size_t)(m_) * DM) + lane; _Pragma("unroll") for (int j_ = 0; j_ < 4; ++j_) T_.v[j_] = xr_[64 * j_]; \
        T_.r0 = TOKR[2 * (m_)]; T_.r1 = TOKR[2 * (m_) + 1]; T_.w0 = TOKW[2 * (m_)]; T_.w1 = TOKW[2 * (m_) + 1]; } while (0)
#define CB_LD2(T_) do { const int a_ = T_.r0 < 128 * 256 ? T_.r0 : 0, b_ = T_.r1 < 128 * 256 ? T_.r1 : 0; const u32x2* ya_ = (const u32x2*)(YP + (size_t)a_ * DM) + lane; const u32x2* yb_ = (const u32x2*)(YP + (size_t)b_ * DM) + lane; \
        _Pragma("unroll") for (int j_ = 0; j_ < 4; ++j_) { T_.y0[j_] = ya_[64 * j_]; T_.y1[j_] = yb_[64 * j_]; } } while (0)
#define CB_DO(T_, m_) do { f32x4* xr = (f32x4*)(x + (size_t)(m_) * DM) + lane; \
        _Pragma("unroll") for (int q = 0; q < 2; ++q) { const int r = q ? T_.r1 : T_.r0; const float wq = q ? T_.w1 : T_.w0; \
            if (r < 128 * 256) { _Pragma("unroll") for (int j = 0; j < 4; ++j) { const u32x2 a = q ? T_.y1[j] : T_.y0[j]; T_.v[j].x += wq * bflo(a.x); T_.v[j].y += wq * bfhi(a.x); T_.v[j].z += wq * bflo(a.y); T_.v[j].w += wq * bfhi(a.y); } } \
            else { _Pragma("unroll 1") for (int pc = 0; pc < pg8::TAIL_PIECES; ++pc) { const u32x2* y = (const u32x2*)(YPT + ((size_t)pc * pg8::TAIL_ROWS + (r - 128 * 256)) * DM) + lane; \
                    _Pragma("unroll") for (int j = 0; j < 4; ++j) { const u32x2 a = y[64 * j]; T_.v[j].x += wq * bflo(a.x); T_.v[j].y += wq * bfhi(a.x); T_.v[j].z += wq * bflo(a.y); T_.v[j].w += wq * bfhi(a.y); } } } } \
        _Pragma("unroll") for (int j = 0; j < 4; ++j) xr[64 * j] = T_.v[j]; } while (0)
    int m = gw; if (m >= NTOK) return;
    Tok ta, tb;
    CB_LD1(ta, m); CB_LD2(ta);
#pragma unroll 1
    for (;;) {
        const int n1 = m + NGW; { const int pf = n1 < NTOK ? n1 : m; CB_LD1(tb, pf); CB_LD2(tb); }
        CB_DO(ta, m);
        if (n1 >= NTOK) break;
        const int n2 = n1 + NGW; { const int pf = n2 < NTOK ? n2 : n1; CB_LD1(ta, pf); CB_LD2(ta); }
        CB_DO(tb, n1);
        if (n2 >= NTOK) break;
        m = n2;
    }
#undef CB_LD1
#undef CB_LD2
#undef CB_DO
}

#ifndef MK_N_LAUNCHES
#define MK_N_LAUNCHES 1
#endif
constexpr int PH_L0 = 9, PH_L1 = 12, N_PHASES = 1 + PH_L0 + PH_L1;
struct Args { const float* in[31]; float* out; unsigned char* ws; int ph_lo, ph_hi, use_bar, pad; };


typedef const __attribute__((address_space(4))) Args* cargs_t;
__device__ __forceinline__ cargs_t kargs() { cargs_t p = (cargs_t)__builtin_amdgcn_kernarg_segment_ptr(); asm volatile("" : "+s"(p)); return p; }
#define AIN(i) ((const float*)(const GAS float*)kargs()->in[i])
#define AWS ((GAS unsigned char*)kargs()->ws)
__device__ __forceinline__ GAS unsigned char* opq(GAS unsigned char* p) { asm volatile("" : "+s"(p)); return p; }
#ifndef DUP17
#define DUP17 1
#endif
#ifndef EN_MASK
#define EN_MASK 0xFFFFFFFFu
#endif
#define EN(b) (((EN_MASK) >> (b)) & 1u)
#define WSV(type, off) ((type*)(GAS type*)(opq(AWS) + (off)))
__global__ void __launch_bounds__(NTHREADS, 2) mk_fwd(Args args) {
    extern __shared__ __attribute__((aligned(16))) unsigned char lds_raw[];
    const int wave_id0 = __builtin_amdgcn_readfirstlane((int)threadIdx.x >> 6);
    volatile LAS unsigned* MISCW = (volatile LAS unsigned*)((LAS unsigned char*)lds_raw + LDS_MISC_OFF);
    if (threadIdx.x < 32) MISCW[threadIdx.x] = 0u;
    __syncthreads();
    if (kargs()->use_bar) (void)xcd_barrier_post((unsigned*)(GAS unsigned*)(AWS + WS_CTL) + CW_BAR, MISCW + 8);
#if defined(PROBE_MASK)
    unsigned long long probe_t0 = __builtin_amdgcn_s_memrealtime(), probe_acc = 0ull;
#endif
#pragma unroll 1
    for (int ph = kargs()->ph_lo; ph < kargs()->ph_hi; ++ph) {
        Ctx F; { unsigned ones_ = ~0u; asm volatile("" : "+s"(ones_));
                 int ln_ = __builtin_amdgcn_mbcnt_hi(ones_, __builtin_amdgcn_mbcnt_lo(ones_, 0u)), wv_ = wave_id0, bx = blockIdx.x, gd = gridDim.x; asm volatile("" : "+v"(ln_)); asm volatile("" : "+s"(bx), "+s"(gd), "+s"(wv_));
                 F.lds = (LAS unsigned char*)lds_raw; F.lane = ln_; F.wave = wv_; F.G = gd; F.vcu = (gd % 8 == 0) ? (bx % 8) * (gd / 8) + bx / 8 : bx; F.bx = bx; }
        const int L = (ph > PH_L0) ? 1 : 0, k = (ph == 0) ? -1 : (ph - 1 - L * PH_L0);
        float* X = (float*)(GAS float*)kargs()->out;
        const float* xin = (L == 0) ? AIN(0) : X;
        const size_t wlo = WS_WL0 + (size_t)L * WS_WL_STRIDE;
        const float* ssq_in = (L == 0) ? nullptr : WSV(float, WS_SSQ + (size_t)NTOK * 64);
        if (EN(0) && k == -1) {
            if (F.tid() == 0) {
                LAS ConvJob* tab = (LAS ConvJob*)(F.lds + CJ_OFF); int nj = 0, tot = 0;
#define CJ_ADD(S_, D_, G_, K_, N_, KIND_) do { int k_ = (K_), n_ = (N_), kd_ = (KIND_); asm volatile("" : "+v"(k_), "+v"(n_), "+v"(kd_));     \
                    tab[nj].src = (S_); tab[nj].dst = (D_); tab[nj].gain = (G_); tab[nj].K = k_; tab[nj].N = n_; tab[nj].kind = kd_; tab[nj].start = tot; tot += (k_ / 64) * ((n_ + 63) / 64); ++nj; } while (0)
#pragma unroll 1
                for (int l2 = 0; l2 < 2; ++l2) {
                    GAS unsigned char* wl = opq(AWS) + WS_WL0 + (size_t)l2 * WS_WL_STRIDE;
                    CJ_ADD(AIN(2) + (size_t)l2 * DM * NIN, (bf16_t*)(GAS bf16_t*)(wl + WO_WIN), l2 ? AIN(1) + DM : nullptr, DM, NIN, 1);
                    CJ_ADD(AIN(14) + (size_t)l2 * 256 * 1536, (bf16_t*)(GAS bf16_t*)(wl + WO_WUQ), nullptr, 256, 1536, 0);
                    CJ_ADD(AIN(16) + (size_t)l2 * 128 * 2048, (bf16_t*)(GAS bf16_t*)(wl + WO_WUKV), nullptr, 128, 2048, 0);
                    CJ_ADD(AIN(19) + (size_t)l2 * DM * DM, (bf16_t*)(GAS bf16_t*)(wl + WO_WBR), nullptr, DM, DM, 0);
                    CJ_ADD(AIN(20) + (size_t)l2 * DM * DM, (bf16_t*)(GAS bf16_t*)(wl + WO_WBR + 2 * MiB), nullptr, DM, DM, 0);
                    CJ_ADD(AIN(21) + (size_t)l2 * DM * DM, (bf16_t*)(GAS bf16_t*)(wl + WO_WBR + 4 * MiB), nullptr, DM, DM, 0);
                    CJ_ADD(AIN(22) + (size_t)l2 * DM * DM, (bf16_t*)(GAS bf16_t*)(wl + WO_WOUT), nullptr, DM, DM, 0);
                }
                CJ_ADD(AIN(24), WSV(bf16_t, WS_WGU), AIN(23), DM, FFD, 2);
                CJ_ADD(AIN(25), WSV(bf16_t, WS_WGU), AIN(23), DM, FFD, 3);
                CJ_ADD(AIN(26), WSV(bf16_t, WS_WDN), nullptr, FFD, DM, 0);
                tab[nj].start = tot;
#undef CJ_ADD
            }
            __syncthreads();
            convert_jobs(F, 17);
#pragma unroll 1
            for (int l2 = 0; l2 < 2; ++l2) { GAS unsigned char* wl = opq(AWS) + WS_WL0 + (size_t)l2 * WS_WL_STRIDE;
                for (int i = F.vcu * NTHREADS + F.tid(); i < 80 * DM / 8; i += F.G * NTHREADS) ((GAS u32x4*)(wl + WO_WIN + (size_t)2736 * DM * 2))[i] = (u32x4){0u, 0u, 0u, 0u}; }
            float* ROPE = WSV(float, WS_ROPE);
            for (int i = F.vcu * NTHREADS + F.tid(); i < SEQ * 16; i += F.G * NTHREADS) { const int pos = i >> 4, kk = i & 15;
                const float inv = __builtin_amdgcn_exp2f(-(float)kk * (13.287712379549449f / 16.0f)), ang = (float)pos * inv; float rev = ang * 0.15915494309189535f; rev -= floorf(rev); ROPE[2 * i] = __builtin_amdgcn_cosf(rev); ROPE[2 * i + 1] = __builtin_amdgcn_sinf(rev); }
            __syncthreads();
            rmsnorm_rows(F, AIN(0), AIN(1), WSV(bf16_t, WS_H));
        }
        else if (EN(2) && k == 0) {
            pg8::Gemm g{WSV(bf16_t, WS_H), WSV(bf16_t, wlo + WO_WIN), NTOK, 20 * 256, DM, DM}; pg8::StaticOrder S; S.init(NTOK, 20 * 256, F.G, F.bx);
            pg8::EpiIn E{WSV(bf16_t, WS_Z), WSV(bf16_t, WS_XBC), WSV(bf16_t, WS_QLAT), WSV(bf16_t, WS_U), WSV(bf16_t, WS_V), WSV(bf16_t, WS_GATES), WSV(float, WS_MISC), 0, ssq_in};
            pg8::gemm_phase<pg8::EpiIn, pg8::StaticOrder, true, true>(F.lds, g, S, E);
        }
        else if (EN(3) && k == 1) {
#ifdef DUP_R
            for (int rep_ = 0; rep_ < DUP_R; ++rep_)
#endif
            mixer_rowpass(F, WSV(bf16_t, WS_QLAT), WSV(float, WS_MISC), WSV(bf16_t, WS_V), AIN(13) + L * 256, AIN(15) + L * 128, WSV(bf16_t, WS_AQ), WSV(bf16_t, WS_AKV), WSV(float, WS_VSTAT));
#ifdef DUP_A
            for (int rep_ = 0; rep_ < DUP_A; ++rep_)
#endif
            ssd_pass_a(F, WSV(bf16_t, WS_XBC), WSV(float, WS_MISC), AIN(3) + L * 4 * 1536, AIN(4) + L * 1536, AIN(5) + L * 16, AIN(6) + L * 16,
                       WSV(bf16_t, WS_STATES), WSV(float, WS_CSG), WSV(float, WS_DTG), WSV(float, WS_CDEC));
        }
        else if (EN(4) && k == 2) {
#pragma unroll 1
            for (int i = 0; i < 2; ++i) {
                const int n = i ? 2048 : 1536, kd = i ? 128 : 256;
                pg8::Gemm g{WSV(bf16_t, i ? WS_AKV : WS_AQ), WSV(bf16_t, wlo + (i ? WO_WUKV : WO_WUQ)), NTOK, n, kd, kd}; pg8::StaticOrder S; S.init(NTOK, n, F.G, F.bx);
                pg8::EpiPlain E{WSV(bf16_t, i ? WS_KVRAW : WS_QRAW), n};
                pg8::gemm_phase<pg8::EpiPlain, pg8::StaticOrder, true, true>(F.lds, g, S, E);
            }
            ssd_scan(F, WSV(bf16_t, WS_STATES), WSV(float, WS_CDEC));
            sgu_phase(F, WSV(bf16_t, WS_U), WSV(bf16_t, WS_V), WSV(float, WS_VSTAT), AIN(9) + L * 1024, AIN(10) + L * 1024, AIN(11) + (size_t)L * 8 * 128 * 128, AIN(12) + L * 8 * 128);
        }
        else if (EN(5) && k == 3) {
            qk_finalize(F, WSV(bf16_t, WS_QRAW), WSV(bf16_t, WS_KVRAW), WSV(float, WS_MISC), AIN(17) + L * 96, AIN(18) + L * 96, WSV(float, WS_ROPE), WSV(bf16_t, WS_K), WSV(bf16_t, WS_VM));
#ifdef DUP_C
            for (int rep_ = 0; rep_ < DUP_C; ++rep_)
#endif
            ssd_pass_c(F, WSV(bf16_t, WS_XBC), WSV(bf16_t, WS_STATES), WSV(float, WS_CSG), WSV(float, WS_DTG), WSV(bf16_t, WS_Z), AIN(3) + L * 4 * 1536, AIN(4) + L * 1536,
                       AIN(7) + L * 16, AIN(8) + L * 1024, WSV(bf16_t, WS_YSSD));
        }
        else if (EN(6) && k == 4) {
            attn_phase(F, WSV(bf16_t, WS_QRAW), WSV(bf16_t, WS_K), WSV(bf16_t, WS_VM), WSV(bf16_t, WS_O), AIN(17) + L * 96, AIN(18) + L * 96);
        }
        else if (EN(7) && k == 5) {
            pg8::Gemm g{WSV(bf16_t, WS_H), WSV(bf16_t, wlo + WO_WIN) + (size_t)20 * 256 * DM, NTOK, 24 * 256, DM, DM};
            pg8::MixOrder S; S.so.init(NTOK, DM, F.G, F.bx); S.aoff[0] = WS_YSSD - WS_H; S.aoff[1] = WS_U - WS_H; S.aoff[2] = WS_O - WS_H;
            S.boff = (WO_WBR - (WO_WIN + (size_t)20 * 256 * DM * 2)) - (size_t)12 * 256 * DM * 2;
            pg8::EpiMix E{WSV(bf16_t, WS_MERGED), WSV(bf16_t, WS_GATES), ssq_in};
            pg8::gemm_phase<pg8::EpiMix, pg8::MixOrder, true, true>(F.lds, g, S, E);
        }
        else if (EN(8) && k == 6) {
            pg8::Gemm g{WSV(bf16_t, WS_MERGED), WSV(bf16_t, wlo + WO_WOUT), NTOK, DM, DM, DM}; pg8::StaticOrder S; S.init(NTOK, DM, F.G, F.bx);
            pg8::EpiResid E{xin, X, (L == 0) ? WSV(bf16_t, WS_H) : nullptr, WSV(float, WS_SSQ)};
            pg8::gemm_phase<pg8::EpiResid, pg8::StaticOrder, true, true>(F.lds, g, S, E);
        }
        else if (EN(9) && L == 0 && k == 7) {
            pg8::Gemm g{WSV(bf16_t, WS_H), WSV(bf16_t, WS_WGU), NTOK, 2 * FFD, DM, DM}; pg8::StaticOrder S; S.init(NTOK, 2 * FFD, F.G, F.bx); pg8::EpiSwiglu E{WSV(bf16_t, WS_HID), FFD, WSV(float, WS_SSQ)};
            pg8::gemm_phase<pg8::EpiSwiglu, pg8::StaticOrder, true, true>(F.lds, g, S, E);
        }
        else if (EN(9) && L == 0 && k == 8) {
            pg8::Gemm g{WSV(bf16_t, WS_HID), WSV(bf16_t, WS_WDN), NTOK, DM, FFD, FFD}; pg8::StaticOrder S; S.init(NTOK, DM, F.G, F.bx);
            pg8::EpiResid E{X, X, WSV(bf16_t, WS_H), WSV(float, WS_SSQ + (size_t)NTOK * 64)};
            pg8::gemm_phase<pg8::EpiResid, pg8::StaticOrder, true, true>(F.lds, g, S, E);
        }
        else if (EN(10) && L == 1 && k == 7) {
            moe_route(F, X, AIN(23) + DM, AIN(27), WSV(unsigned, WS_CTL) + CW_CNT, WSV(float, WS_RSTD), WSV(int, WS_TOKE), WSV(int, WS_TOKP), WSV(float, WS_TOKW));
            convert_moe(F, AIN(28), AIN(29), AIN(30), WSV(bf16_t, WS_WMGU), WSV(bf16_t, WS_WMDN));
#if DUP17 > 1
#pragma unroll 1
            for (int e = 0; e < NEXP; ++e) {
                convert_probe<DUP17 - 1>(F, AIN(28) + (size_t)e * DM * FFE, DM, FFE, WSV(bf16_t, WS_AG) + (size_t)e * 3 * FFE * DM);
                convert_probe<DUP17 - 1>(F, AIN(29) + (size_t)e * DM * FFE, DM, FFE, WSV(bf16_t, WS_AG) + (size_t)e * 3 * FFE * DM + (size_t)FFE * DM);
                convert_probe<DUP17 - 1>(F, AIN(30) + (size_t)e * FFE * DM, FFE, DM, WSV(bf16_t, WS_AG) + (size_t)e * 3 * FFE * DM + (size_t)2 * FFE * DM);
            }
#endif
            __syncthreads();
        }
        else if (EN(10) && L == 1 && k == 8) {
            moe_scatter(F, X, AIN(23) + DM, WSV(unsigned, WS_CTL) + CW_CNT, WSV(float, WS_RSTD), WSV(int, WS_TOKE), WSV(int, WS_TOKP), WSV(int, WS_TOKR), WSV(bf16_t, WS_AG));
        }
        else if (EN(10) && L == 1 && k == 9) {
            int off[9]; moe_offsets(WSV(unsigned, WS_CTL) + CW_CNT, off);
            pg8::Gemm g{WSV(bf16_t, WS_AG), WSV(bf16_t, WS_WMGU), off[8], 2 * FFE, DM, DM}; pg8::MoeOrder S; S.so.init(off[8], 2 * FFE, F.G, F.bx); S.estride = (size_t)2 * FFE * DM * 2;
#pragma unroll
            for (int e = 0; e < 9; ++e) S.toff[e] = off[e] >> 8;
            pg8::EpiSwiglu E{WSV(bf16_t, WS_HIDM), FFE, nullptr};
            pg8::gemm_phase<pg8::EpiSwiglu, pg8::MoeOrder, true, true>(F.lds, g, S, E);
        }
        else if (EN(10) && L == 1 && k == 10) {
            int off[9]; moe_offsets(WSV(unsigned, WS_CTL) + CW_CNT, off);
            { pg8::Gemm g{WSV(bf16_t, WS_HIDM), WSV(bf16_t, WS_WMDN), 128 * 256, DM, FFE, FFE}; pg8::MoeOrder S; S.so.init(128 * 256, DM, F.G, F.bx); S.estride = (size_t)DM * FFE * 2;
#pragma unroll
              for (int e = 0; e < 9; ++e) S.toff[e] = off[e] >> 8;
              pg8::EpiPlain E{WSV(bf16_t, WS_YP), DM};
              pg8::gemm_phase<pg8::EpiPlain, pg8::MoeOrder, true, true>(F.lds, g, S, E); }
            { pg8::Gemm g{WSV(bf16_t, WS_HIDM), WSV(bf16_t, WS_WMDN), off[8], DM, 512, FFE}; pg8::TailOrder S; S.ntail = ((off[8] >> 8) - 128) * 4; S.c = F.vcu; S.estride = (size_t)DM * FFE * 2;
#pragma unroll
              for (int e = 0; e < 9; ++e) S.toff[e] = off[e] >> 8;
              pg8::EpiTail E{WSV(bf16_t, WS_YPT)};
              pg8::gemm_phase<pg8::EpiTail, pg8::TailOrder, true, true>(F.lds, g, S, E); }
        }
        else if (EN(10) && L == 1 && k == 11) {
            moe_combine(F, X, WSV(bf16_t, WS_YP), WSV(bf16_t, WS_YPT), WSV(int, WS_TOKR), WSV(float, WS_TOKW));
        }
#if defined(PROBE_MASK)
        const unsigned long long pt0_ = probe_t0;
#endif
        if (ph + 1 < kargs()->ph_hi) { XcdBarrier b2; b2.bar = (unsigned*)(GAS unsigned*)(opq(AWS) + WS_CTL) + CW_BAR; b2.x = xb_xcc_id(); b2.st = MISCW + 8; xcd_barrier(b2); }
#if defined(PROBE_MASK)
        { const unsigned long long now = __builtin_amdgcn_s_memrealtime(); if ((PROBE_MASK >> ph) & 1ull) probe_acc += now - pt0_; probe_t0 = now; }
#endif
    }
#if defined(DUP_BAR)
    for (int xb_ = 0; xb_ < DUP_BAR; ++xb_) { XcdBarrier b2; b2.bar = (unsigned*)(GAS unsigned*)(opq(AWS) + WS_CTL) + CW_BAR; b2.x = xb_xcc_id(); b2.st = MISCW + 8; xcd_barrier(b2); }
#endif
#if defined(PROBE_MASK)
    { const unsigned long long until = __builtin_amdgcn_s_memrealtime() + (unsigned long long)(PROBE_MULT) * probe_acc; while (__builtin_amdgcn_s_memrealtime() < until) __builtin_amdgcn_s_sleep(8); }
#endif
}

extern "C" void kernel_launch(void* const* d_in, const int* in_sizes, int n_in, void* d_out, int out_size, void* d_ws, size_t ws_size, hipStream_t stream) {
    static int grid = 0;
    if (grid == 0) {
        if (n_in != 31 || in_sizes[0] != NTOK * DM || out_size != NTOK * DM || ws_size < WS_END) {
            fprintf(stderr, "kernel_launch: unexpected problem (n_in %d, in0 %d, out %d, ws %zu < %zu?); nothing launched\n", n_in, n_in > 0 ? in_sizes[0] : -1, out_size, ws_size, (size_t)WS_END); grid = -1; return; }
        int dev = 0, cus = 0, per_cu = 0;
        if (hipGetDevice(&dev) != hipSuccess || hipDeviceGetAttribute(&cus, hipDeviceAttributeMultiprocessorCount, dev) != hipSuccess) { grid = -1; return; }
        if (hipFuncSetAttribute((const void*)mk_fwd, hipFuncAttributeMaxDynamicSharedMemorySize, LDS_BYTES) != hipSuccess) { fprintf(stderr, "kernel_launch: hipFuncSetAttribute failed\n"); grid = -1; return; }
        if (hipOccupancyMaxActiveBlocksPerMultiprocessor(&per_cu, (const void*)mk_fwd, NTHREADS, LDS_BYTES) != hipSuccess || per_cu < 1) fprintf(stderr, "kernel_launch: occupancy query reports %d blocks per CU\n", per_cu);
        (void)hipGetLastError();
        grid = cus;
        if (grid != 256) { fprintf(stderr, "kernel_launch: this kernel is built for a 256-CU device (got %d)\n", grid); grid = -1; return; }
    }
    if (grid < 0) return;
    if (hipMemsetAsync((char*)d_ws + WS_CTL, 0, CTL_ZERO_BYTES, stream) != hipSuccess) return;
    Args a{};
    for (int i = 0; i < 31; ++i) a.in[i] = (const float*)d_in[i];
    a.out = (float*)d_out; a.ws = (unsigned char*)d_ws;
#if MK_N_LAUNCHES == 1
    a.ph_lo = 0; a.ph_hi = N_PHASES; a.use_bar = 1;
    hipLaunchKernelGGL(mk_fwd, dim3(grid), dim3(NTHREADS), LDS_BYTES, stream, a);
#else
    for (int p = 0; p < N_PHASES; ++p) { a.ph_lo = p; a.ph_hi = p + 1; a.use_bar = 0; hipLaunchKernelGGL(mk_fwd, dim3(grid), dim3(NTHREADS), LDS_BYTES, stream, a); }
#endif
}
```

```cpp
#include <hip/hip_runtime.h>
#include <cstdio>
#include <cstdint>
namespace pg8 {
#define PG8_LAS __attribute__((address_space(3)))
typedef unsigned short bf16_t;
typedef short bf16x8 __attribute__((ext_vector_type(8)));
typedef float f32x4 __attribute__((ext_vector_type(4)));
typedef unsigned u32x4 __attribute__((ext_vector_type(4)));
constexpr int BM = 256, BK = 64, HALF = 128, HTB = HALF * BK * 2  , STAGE_BYTES = 8 * HTB, NXCD = 8, WGM = 2;

__host__ __device__ __forceinline__ int lds_byte(int r, int c) { const int st = (r >> 4) * 2 + (c >> 5), rr = r & 15, cc = c & 31, ob = rr * 64 + cc * 2; return st * 1024 + (ob ^ (((ob >> 9) & 1) << 5)); }
__host__ __device__ __forceinline__ void stage_rc(int b, int& R, int& C) { const int st = b / 1024, sb = b % 1024, swz = sb ^ (((sb >> 9) & 1) << 5); R = (st >> 1) * 16 + swz / 64; C = (st & 1) * 32 + (swz % 64) / 2; }
__host__ __device__ __forceinline__ int perm32(int rho) { const int n = rho >> 4, i = rho & 15; return 8 * (i >> 2) + 4 * n + (i & 3); }

struct Unit { int pm, pn; };
struct Gemm { const bf16_t* A; const bf16_t* Bt; int M, N, K, ld; };

struct StaticOrder {
    int nM, nN, nwg, G, c, wgm;
    __host__ __device__ void init(int M, int N, int G_, int c_, int wgm_ = WGM) { nM = M / BM; nN = N / BM; nwg = nM * nN; G = G_; c = c_; wgm = wgm_; }
    __host__ __device__ bool next(int i, Unit& u) const {
        const long L = (long)i * G + c; if (L >= nwg) return false;
        int wgid = (int)L; { const int q = nwg / NXCD, r = nwg % NXCD, xcd = wgid % NXCD, off = wgid / NXCD; wgid = (xcd < r ? xcd * (q + 1) : r * (q + 1) + (xcd - r) * q) + off; }
        const int nig = wgm * nN, gid = wgid / nig, fm = gid * wgm, gsz = (nM - fm) < wgm ? (nM - fm) : wgm;
        u.pm = fm + ((wgid % nig) % gsz); u.pn = (wgid % nig) / gsz; return true;
    }
    __device__ __forceinline__ void a_ready(const Unit&) const {}
    __device__ __forceinline__ size_t b_off(const Unit&) const { return 0; }
    __device__ __forceinline__ size_t a_off(const Unit&) const { return 0; }
    __device__ __forceinline__ void done(const Unit&) const {}
};

__device__ __forceinline__ unsigned cvt_pk_bf16(float lo, float hi) { unsigned r; asm volatile("v_cvt_pk_bf16_f32 %0, %1, %2" : "=v"(r) : "v"(lo), "v"(hi)); return r; }
typedef float f32x2 __attribute__((ext_vector_type(2)));
__device__ __forceinline__ f32x2 gelu_pk(f32x2 v) {
    const f32x2 av = __builtin_elementwise_abs(v), d = av * 0.2316418882f + 1.0f;
    f32x2 t; t.x = __builtin_amdgcn_rcpf(d.x); t.y = __builtin_amdgcn_rcpf(d.y);
    f32x2 q = t * 0.5307027145f + (-0.7265760135f); q = q * t + 0.7107068705f; q = q * t + (-0.142248368f); q = q * t + 0.127414796f; q = q * t;
    const f32x2 s = (v * v) * (-0.72134752044f);
    f32x2 e; e.x = __builtin_amdgcn_exp2f(s.x); e.y = __builtin_amdgcn_exp2f(s.y);
    const f32x2 m = v * (q * e), r = v - m;
    f32x2 o; o.x = v.x < 0.f ? m.x : r.x; o.y = v.y < 0.f ? m.y : r.y; return o;
}

__device__ __forceinline__ unsigned pkbf(float lo, float hi) { typedef __bf16 b2_t __attribute__((ext_vector_type(2))); f32x2 v = {lo, hi}; b2_t b = __builtin_convertvector(v, b2_t); return __builtin_bit_cast(unsigned, b); }
__device__ __forceinline__ float bflo(unsigned w) { return __uint_as_float(w << 16); }
__device__ __forceinline__ float bfhi(unsigned w) { return __uint_as_float(w & 0xffff0000u); }
__device__ __forceinline__ float fsigmoid(float x) { return __builtin_amdgcn_rcpf(1.0f + __builtin_amdgcn_exp2f(-1.4426950408889634f * x)); }
template <int ACT> __device__ __forceinline__ f32x4 act4(f32x4 v) {
    if (ACT == 1) { v[0] *= fsigmoid(v[0]); v[1] *= fsigmoid(v[1]); v[2] *= fsigmoid(v[2]); v[3] *= fsigmoid(v[3]); }
    if (ACT == 2) { const f32x2 a = gelu_pk((f32x2){v[0], v[1]}), b = gelu_pk((f32x2){v[2], v[3]}); v = (f32x4){a.x, a.y, b.x, b.y}; }
    if (ACT == 3) { v[0] = fsigmoid(v[0]); v[1] = fsigmoid(v[1]); v[2] = fsigmoid(v[2]); v[3] = fsigmoid(v[3]); }
    return v;
}
__device__ __forceinline__ void row_scales(const float* ssq, int row0, int fq, float (&rs)[2][4]) {
    if (!ssq) {
#pragma unroll
        for (int ai = 0; ai < 2; ++ai)
#pragma unroll
            for (int m = 0; m < 4; ++m) rs[ai][m] = 1.0f;
        return; }
    const int lane = (row0 & 15) | (fq << 4); f32x4 q[2][4];
#pragma unroll
    for (int ai = 0; ai < 2; ++ai)
#pragma unroll
        for (int m = 0; m < 4; ++m) q[ai][m] = *(const f32x4*)(ssq + (size_t)(row0 + ai * HALF + m * 16) * 16 + 4 * fq);
#pragma unroll
    for (int ai = 0; ai < 2; ++ai)
#pragma unroll
        for (int m = 0; m < 4; ++m) { float t = (q[ai][m].x + q[ai][m].y) + (q[ai][m].z + q[ai][m].w);
            t += __int_as_float(__builtin_amdgcn_ds_bpermute((lane ^ 16) << 2, __float_as_int(t))); t += __int_as_float(__builtin_amdgcn_ds_bpermute((lane ^ 32) << 2, __float_as_int(t)));
            rs[ai][m] = 1.0f / sqrtf(t * (1.0f / 1024.0f) + 1e-6f); }
}
template <int ACT> __device__ __forceinline__ void store_tile_bf16(const f32x4 (&acc)[2][2][4][2], bf16_t* base, int ld, int row0, int col0, const float (&rs)[2][4]) {
#pragma unroll
    for (int ai = 0; ai < 2; ++ai)
#pragma unroll
        for (int m = 0; m < 4; ++m) { bf16_t* rowp = base + (size_t)(row0 + ai * HALF + m * 16) * ld + col0;
#pragma unroll
            for (int bj = 0; bj < 2; ++bj) { const f32x4 v0 = act4<ACT>(acc[ai][bj][m][0] * rs[ai][m]), v1 = act4<ACT>(acc[ai][bj][m][1] * rs[ai][m]);
                u32x4 w; w.x = pkbf(v0[0], v0[1]); w.y = pkbf(v0[2], v0[3]); w.z = pkbf(v1[0], v1[1]); w.w = pkbf(v1[2], v1[3]);
                *(u32x4*)(rowp + bj * HALF) = w; } }
}
struct EpiIn {
    static constexpr bool PERM = true, AFTER_DRAIN = false;
    bf16_t *Z, *XBC, *QLAT, *U, *V, *GATES; float* MISC; int pn_base; const float* ssq;
    __device__ __forceinline__ void operator()(const f32x4 (&acc)[2][2][4][2], const Unit& u, int wr, int wc, int fr, int fq) const {
        const int pn = u.pn + pn_base, row0 = u.pm * BM + wr * 64 + fr, cw = wc * 32 + 8 * fq;
        float rs[2][4]; row_scales(ssq, row0, fq, rs);
        if (pn < 4) store_tile_bf16<1>(acc, Z, 1024, row0, pn * 256 + cw, rs);
        else if (pn < 10) store_tile_bf16<0>(acc, XBC, 1536, row0, (pn - 4) * 256 + cw, rs);
        else if (pn == 10) {
#pragma unroll
            for (int ai = 0; ai < 2; ++ai)
#pragma unroll
                for (int m = 0; m < 4; ++m) { float* rowp = MISC + (size_t)(row0 + ai * HALF + m * 16) * 256 + cw;
#pragma unroll
                    for (int bj = 0; bj < 2; ++bj) { *(f32x4*)(rowp + bj * HALF) = acc[ai][bj][m][0] * rs[ai][m]; *(f32x4*)(rowp + bj * HALF + 4) = acc[ai][bj][m][1] * rs[ai][m]; } }
        }
        else if (pn == 11) store_tile_bf16<0>(acc, QLAT, 256, row0, cw, rs);
        else if (pn < 16) store_tile_bf16<2>(acc, U, 1024, row0, (pn - 12) * 256 + cw, rs);
        else if (pn < 20) store_tile_bf16<2>(acc, V, 1024, row0, (pn - 16) * 256 + cw, rs);
        else store_tile_bf16<3>(acc, GATES, 3072, row0, (pn - 20) * 256 + cw, rs);
    }
};
struct EpiPlain {
    static constexpr bool PERM = true, AFTER_DRAIN = false;
    bf16_t* O; int ld;
    __device__ __forceinline__ void operator()(const f32x4 (&acc)[2][2][4][2], const Unit& u, int wr, int wc, int fr, int fq) const {
        float rs[2][4]; row_scales(nullptr, 0, 0, rs); store_tile_bf16<0>(acc, O, ld, u.pm * BM + wr * 64 + fr, u.pn * BM + wc * 32 + 8 * fq, rs);
    }
};
struct EpiQKV {
    static constexpr bool PERM = true, AFTER_DRAIN = false;
    bf16_t* O; int ld; bf16_t* V; int split;
    __device__ __forceinline__ void operator()(const f32x4 (&acc)[2][2][4][2], const Unit& u, int wr, int wc, int fr, int fq) const {
        float rs[2][4]; row_scales(nullptr, 0, 0, rs); const int row0 = u.pm * BM + wr * 64 + fr;
        if (!split) store_tile_bf16<0>(acc, O, ld, row0, u.pn * BM + wc * 32 + 8 * fq, rs);
        else { bf16_t* base = (wc < 2) ? O : V; const int c0 = u.pn * 128 + (wc & 1) * 32 + 8 * fq;
#pragma unroll
            for (int ai = 0; ai < 2; ++ai)
#pragma unroll
                for (int m = 0; m < 4; ++m) { bf16_t* rowp = base + (size_t)(row0 + ai * HALF + m * 16) * 1024 + c0;
#pragma unroll
                    for (int bj = 0; bj < 2; ++bj) { const f32x4 v0 = acc[ai][bj][m][0], v1 = acc[ai][bj][m][1];
                        u32x4 w; w.x = pkbf(v0[0], v0[1]); w.y = pkbf(v0[2], v0[3]); w.z = pkbf(v1[0], v1[1]); w.w = pkbf(v1[2], v1[3]);
                        *(u32x4*)(rowp + bj * 64) = w; } } }
    }
};
typedef unsigned u32x2g __attribute__((ext_vector_type(2)));
__device__ __forceinline__ void store_gates_u8(const f32x4 (&acc)[2][2][4][2], unsigned char* G8, int row0, int col0, const float (&rs)[2][4]) {
#pragma unroll
    for (int ai = 0; ai < 2; ++ai)
#pragma unroll
        for (int m = 0; m < 4; ++m) { unsigned char* rowp = G8 + (size_t)(row0 + ai * HALF + m * 16) * 3072 + col0;
#pragma unroll
            for (int bj = 0; bj < 2; ++bj) { const f32x4 v0 = act4<3>(acc[ai][bj][m][0] * rs[ai][m]), v1 = act4<3>(acc[ai][bj][m][1] * rs[ai][m]);
                const unsigned q0 = (unsigned)(v0[0] * 255.0f + 0.5f), q1 = (unsigned)(v0[1] * 255.0f + 0.5f), q2 = (unsigned)(v0[2] * 255.0f + 0.5f), q3 = (unsigned)(v0[3] * 255.0f + 0.5f);
                const unsigned q4 = (unsigned)(v1[0] * 255.0f + 0.5f), q5 = (unsigned)(v1[1] * 255.0f + 0.5f), q6 = (unsigned)(v1[2] * 255.0f + 0.5f), q7 = (unsigned)(v1[3] * 255.0f + 0.5f);
                u32x2g w; w.x = q0 | (q1 << 8) | (q2 << 16) | (q3 << 24); w.y = q4 | (q5 << 8) | (q6 << 16) | (q7 << 24);
                *(u32x2g*)(rowp + bj * HALF) = w; } }
}
template <int MODE> __device__ __forceinline__ void gate_accumulate(const f32x4 (&acc)[2][2][4][2], bf16_t* MG, const bf16_t* GATES, int goff, int row0, int col0) {
#pragma unroll
    for (int ai = 0; ai < 2; ++ai) { u32x2g gw[4][2]; u32x4 ov[4][2];
#pragma unroll
        for (int m = 0; m < 4; ++m)
#pragma unroll
            for (int bj = 0; bj < 2; ++bj) { const size_t r = (size_t)(row0 + ai * HALF + m * 16); const int c = col0 + bj * HALF;
                gw[m][bj] = *(const u32x2g*)((const unsigned char*)GATES + r * 3072 + goff + c); if (MODE) ov[m][bj] = *(const u32x4*)(MG + r * 1024 + c); }
#pragma unroll
        for (int m = 0; m < 4; ++m)
#pragma unroll
            for (int bj = 0; bj < 2; ++bj) { const size_t r = (size_t)(row0 + ai * HALF + m * 16); const int c = col0 + bj * HALF; const u32x2g g = gw[m][bj]; constexpr float K255 = 1.0f / 255.0f;
                f32x4 v0 = acc[ai][bj][m][0], v1 = acc[ai][bj][m][1];
                v0[0] *= (float)(g.x & 0xffu) * K255; v0[1] *= (float)((g.x >> 8) & 0xffu) * K255; v0[2] *= (float)((g.x >> 16) & 0xffu) * K255; v0[3] *= (float)(g.x >> 24) * K255;
                v1[0] *= (float)(g.y & 0xffu) * K255; v1[1] *= (float)((g.y >> 8) & 0xffu) * K255; v1[2] *= (float)((g.y >> 16) & 0xffu) * K255; v1[3] *= (float)(g.y >> 24) * K255;
                if (MODE) { const u32x4 o = ov[m][bj];
                    v0[0] += bflo(o.x); v0[1] += bfhi(o.x); v0[2] += bflo(o.y); v0[3] += bfhi(o.y);
                    v1[0] += bflo(o.z); v1[1] += bfhi(o.z); v1[2] += bflo(o.w); v1[3] += bfhi(o.w); }
                u32x4 w; w.x = pkbf(v0[0], v0[1]); w.y = pkbf(v0[2], v0[3]); w.z = pkbf(v1[0], v1[1]); w.w = pkbf(v1[2], v1[3]);
                *(u32x4*)(MG + r * 1024 + c) = w; } }
}
struct EpiMix {
    static constexpr bool PERM = true, AFTER_DRAIN = false;
    bf16_t* MG; bf16_t* GATES; const float* ssq;
    __device__ __forceinline__ void operator()(const f32x4 (&acc)[2][2][4][2], const Unit& u, int wr, int wc, int fr, int fq) const {
        const int row0 = u.pm * BM + wr * 64 + fr, cw = wc * 32 + 8 * fq;
        if (u.pn < 12) { float rs[2][4]; row_scales(ssq, row0, fq, rs); store_gates_u8(acc, (unsigned char*)GATES, row0, u.pn * 256 + cw, rs); }
        else { const int i = (u.pn - 12) >> 2, ct = (u.pn - 12) & 3; if (i == 0) gate_accumulate<0>(acc, MG, GATES, 0, row0, ct * 256 + cw); else gate_accumulate<1>(acc, MG, GATES, i * 1024, row0, ct * 256 + cw); }
    }
};
struct EpiResid {
    static constexpr bool PERM = true, AFTER_DRAIN = false;
    const float* base32; const bf16_t* base16; bf16_t* out; float* ssq;
    __device__ __forceinline__ void operator()(const f32x4 (&acc)[2][2][4][2], const Unit& u, int wr, int wc, int fr, int fq) const {
        const int row0 = u.pm * BM + wr * 64 + fr, col0 = u.pn * BM + wc * 32 + 8 * fq, lane = fr | (fq << 4);
#pragma unroll
        for (int ai = 0; ai < 2; ++ai) {
            f32x4 b0[4][2], b1[4][2];
#pragma unroll
            for (int m = 0; m < 4; ++m)
#pragma unroll
                for (int bj = 0; bj < 2; ++bj) { const size_t off = (size_t)(row0 + ai * HALF + m * 16) * 1024 + col0 + bj * HALF;
                    if (base32) { b0[m][bj] = *(const f32x4*)(base32 + off); b1[m][bj] = *(const f32x4*)(base32 + off + 4); }
                    else { const u32x4 b = *(const u32x4*)(base16 + off); b0[m][bj] = __builtin_bit_cast(f32x4, b); } }
#pragma unroll
            for (int m = 0; m < 4; ++m) { const size_t r = (size_t)(row0 + ai * HALF + m * 16); float sq = 0.f;
#pragma unroll
                for (int bj = 0; bj < 2; ++bj) { const size_t off = r * 1024 + col0 + bj * HALF; f32x4 v0, v1;
                    if (base32) { v0 = b0[m][bj]; v1 = b1[m][bj]; }
                    else { const u32x4 b = __builtin_bit_cast(u32x4, b0[m][bj]); v0 = (f32x4){bflo(b.x), bfhi(b.x), bflo(b.y), bfhi(b.y)}; v1 = (f32x4){bflo(b.z), bfhi(b.z), bflo(b.w), bfhi(b.w)}; }
                    v0 = v0 + acc[ai][bj][m][0]; v1 = v1 + acc[ai][bj][m][1];
                    u32x4 w; w.x = pkbf(v0[0], v0[1]); w.y = pkbf(v0[2], v0[3]); w.z = pkbf(v1[0], v1[1]); w.w = pkbf(v1[2], v1[3]); *(u32x4*)(out + off) = w;
                    if (ssq) sq += (v0[0] * v0[0] + v0[1] * v0[1]) + (v0[2] * v0[2] + v0[3] * v0[3]) + (v1[0] * v1[0] + v1[1] * v1[1]) + (v1[2] * v1[2] + v1[3] * v1[3]); }
                if (ssq) { sq += __int_as_float(__builtin_amdgcn_ds_bpermute((lane ^ 16) << 2, __float_as_int(sq))); sq += __int_as_float(__builtin_amdgcn_ds_bpermute((lane ^ 32) << 2, __float_as_int(sq)));
                    if (fq == 0) ssq[r * 16 + u.pn * 4 + wc] = sq; } } }
    }
};
struct EpiSwiglu {
    static constexpr bool PERM = true, AFTER_DRAIN = false;
    bf16_t* O; int ld; const float* ssq;
    __device__ __forceinline__ void operator()(const f32x4 (&acc)[2][2][4][2], const Unit& u, int wr, int wc, int fr, int fq) const {
        const int row0 = u.pm * BM + wr * 64 + fr, col0 = u.pn * HALF + wc * 32 + 8 * fq;
        float rs[2][4]; row_scales(ssq, row0, fq, rs);
#pragma unroll
        for (int ai = 0; ai < 2; ++ai)
#pragma unroll
            for (int m = 0; m < 4; ++m) {
                const f32x4 g0 = act4<1>(acc[ai][0][m][0] * rs[ai][m]), g1 = act4<1>(acc[ai][0][m][1] * rs[ai][m]); const f32x4 v0 = g0 * (acc[ai][1][m][0] * rs[ai][m]), v1 = g1 * (acc[ai][1][m][1] * rs[ai][m]);
                u32x4 w; w.x = pkbf(v0[0], v0[1]); w.y = pkbf(v0[2], v0[3]); w.z = pkbf(v1[0], v1[1]); w.w = pkbf(v1[2], v1[3]);
                *(u32x4*)(O + (size_t)(row0 + ai * HALF + m * 16) * ld + col0) = w; }
    }
};
struct MixOrder {
    StaticOrder so; size_t aoff[3]; size_t boff;
    __device__ __forceinline__ bool next(int i, Unit& u) const { if (i >= 6) return false; Unit b; if (!so.next(0, b)) return false; u.pm = b.pm;
        u.pn = (i & 1) ? 12 + 4 * (i >> 1) + b.pn : 4 * (i >> 1) + b.pn; return true; }
    __device__ __forceinline__ void a_ready(const Unit&) const {}
    __device__ __forceinline__ size_t a_off(const Unit& u) const { return u.pn < 12 ? (size_t)0 : (u.pn < 16 ? aoff[0] : (u.pn < 20 ? aoff[1] : aoff[2])); }
    __device__ __forceinline__ size_t b_off(const Unit& u) const { return u.pn < 12 ? (size_t)0 : boff; }
    __device__ __forceinline__ void done(const Unit&) const {}
};
struct MoeOrder {
    StaticOrder so; int toff[9]; size_t estride;
    __device__ __forceinline__ bool next(int i, Unit& u) const { return so.next(i, u); }
    __device__ __forceinline__ void a_ready(const Unit&) const {}
    __device__ __forceinline__ size_t a_off(const Unit&) const { return 0; }
    __device__ __forceinline__ size_t b_off(const Unit& u) const { int e = 0;
#pragma unroll
        for (int k = 1; k < 8; ++k) e += (u.pm >= toff[k]) ? 1 : 0;
        return (size_t)e * estride; }
    __device__ __forceinline__ void done(const Unit&) const {}
};

constexpr int TAIL_PIECES = 7, TAIL_ROWS = 8 * 256;
struct TailOrder {
    int ntail, c, toff[9]; size_t estride;
    __device__ __forceinline__ bool next(int i, Unit& u) const { if (i > 0) return false; const int t = c / TAIL_PIECES, piece = c % TAIL_PIECES; if (t >= ntail) return false; u.pm = 128 + (t >> 2); u.pn = (t & 3) + 4 * piece; return true; }
    __device__ __forceinline__ void a_ready(const Unit&) const {}
    __device__ __forceinline__ size_t a_off(const Unit& u) const { return (size_t)(u.pn >> 2) * 512 * 2; }
    __device__ __forceinline__ size_t b_off(const Unit& u) const { int e = 0;
#pragma unroll
        for (int k = 1; k < 8; ++k) e += (u.pm >= toff[k]) ? 1 : 0;
        const size_t piece = (size_t)(u.pn >> 2); return (size_t)e * estride + piece * 512 * 2 - piece * 4 * (size_t)(256 * 3584 * 2); }
    __device__ __forceinline__ void done(const Unit&) const {}
};
struct EpiTail {
    static constexpr bool PERM = true, AFTER_DRAIN = false;
    bf16_t* P;
    __device__ __forceinline__ void operator()(const f32x4 (&acc)[2][2][4][2], const Unit& u, int wr, int wc, int fr, int fq) const {
        float rs[2][4]; row_scales(nullptr, 0, 0, rs);
        store_tile_bf16<0>(acc, P + (size_t)(u.pn >> 2) * TAIL_ROWS * 1024, 1024, (u.pm - 128) * BM + wr * 64 + fr, (u.pn & 3) * BM + wc * 32 + 8 * fq, rs);
    }
};
template <class Epi, class Sched, bool ALIGN_EPI = false, bool SP2 = false>
__device__ __forceinline__ void gemm_phase(PG8_LAS unsigned char* lds, const Gemm g, const Sched& S, const Epi& E) {
    int tid_ = threadIdx.x; asm volatile("" : "+v"(tid_));
    const int tid = tid_, wid = __builtin_amdgcn_readfirstlane(tid >> 6), lane = tid & 63, wr = wid >> 2, wc = wid & 3, fr = lane & 15, fq = lane >> 4;
    const int K = g.ld, nt = g.K / BK;
    unsigned voffA[2], voffB[2];
#pragma unroll
    for (int i = 0; i < 2; ++i) { int R, C; stage_rc(tid * 16 + i * 8192, R, C); const int Rb = Epi::PERM ? ((R & ~31) + perm32(R & 31)) : R;
        voffA[i] = (unsigned)(R * K + C) * 2u; voffB[i] = (unsigned)(Rb * K + C) * 2u; }
    const size_t kstep = (size_t)(BK * 2);
    const size_t hstep = (size_t)HALF * K * 2;
    const size_t tstep = 2 * hstep;
    const unsigned ldsw = (unsigned)wid * 1024u;
    const int aoff = lds_byte(wr * 64 + fr, fq * 8), boff = lds_byte(wc * 32 + fr, fq * 8);
#define PG8_SA(b, h) (((b) * 2 + (h)) * HTB)
#define PG8_SB(b, h) ((4 + (b) * 2 + (h)) * HTB)
#define PG8_STAGE(bufoff, gbase, voff) do { _Pragma("unroll") for (int _i = 0; _i < 2; ++_i) \
        __builtin_amdgcn_global_load_lds((const unsigned*)((const char*)(gbase) + (voff)[_i]), (PG8_LAS unsigned*)(lds + (bufoff) + ldsw + _i * 8192), 16, 0, 0); } while (0)
#define PG8_LDA(dst, b, h) do { _Pragma("unroll") for (int m = 0; m < 4; ++m) _Pragma("unroll") for (int k = 0; k < 2; ++k) dst[m][k] = *(const PG8_LAS bf16x8*)(lds + PG8_SA(b, h) + aoff + m * 2048 + k * 1024); } while (0)
#define PG8_LDB(dst, b, h) do { _Pragma("unroll") for (int n = 0; n < 2; ++n) _Pragma("unroll") for (int k = 0; k < 2; ++k) dst[n][k] = *(const PG8_LAS bf16x8*)(lds + PG8_SB(b, h) + boff + n * 2048 + k * 1024); } while (0)
#define PG8_MMA(ai, bj, At, Bt) do { __builtin_amdgcn_s_setprio(1); _Pragma("unroll") for (int m = 0; m < 4; ++m) _Pragma("unroll") for (int n = 0; n < 2; ++n) _Pragma("unroll") for (int k = 0; k < 2; ++k) \
        acc[ai][bj][m][n] = __builtin_amdgcn_mfma_f32_16x16x32_bf16(Bt[n][k], At[m][k], acc[ai][bj][m][n], 0, 0, 0); __builtin_amdgcn_s_setprio(0); } while (0)
#define PG8_WAIT_V(n) asm volatile("s_waitcnt vmcnt(" #n ")" ::: "memory")
#define PG8_WAIT_L(n) asm volatile("s_waitcnt lgkmcnt(" #n ")" ::: "memory")
#define PG8_BAR __builtin_amdgcn_s_barrier()
#define PG8_SCHED __builtin_amdgcn_sched_barrier(0)
    Unit cur, nxt; int ui = 0;
    if (!S.next(0, cur)) return;
    f32x4 acc[2][2][4][2];
#pragma unroll
    for (int a = 0; a < 2; ++a)
#pragma unroll
        for (int b = 0; b < 2; ++b)
#pragma unroll
            for (int m = 0; m < 4; ++m)
#pragma unroll
                for (int n = 0; n < 2; ++n) acc[a][b][m][n] = (f32x4){0.f, 0.f, 0.f, 0.f};
    bf16x8 At[4][2], B0[2][2], B1[2][2];
    const char* cA = (const char*)g.A + S.a_off(cur) + (size_t)cur.pm * tstep; const char* cB = (const char*)g.Bt + S.b_off(cur) + (size_t)cur.pn * tstep;
    S.a_ready(cur);
    if constexpr (SP2) {
        PG8_STAGE(PG8_SB(0, 0), cB, voffB); PG8_STAGE(PG8_SB(0, 1), cB + hstep, voffB); PG8_STAGE(PG8_SA(0, 0), cA, voffA); PG8_STAGE(PG8_SA(0, 1), cA + hstep, voffA);
        if (wr == 1) PG8_BAR;
        PG8_WAIT_V(2); PG8_BAR;
        PG8_STAGE(PG8_SB(1, 0), cB + kstep, voffB); PG8_STAGE(PG8_SA(1, 0), cA + kstep, voffA); PG8_STAGE(PG8_SB(1, 1), cB + hstep + kstep, voffB);
        PG8_WAIT_V(6); PG8_BAR;
    } else {
        PG8_STAGE(PG8_SB(0, 0), cB, voffB); PG8_STAGE(PG8_SA(0, 0), cA, voffA); PG8_STAGE(PG8_SB(0, 1), cB + hstep, voffB); PG8_STAGE(PG8_SA(0, 1), cA + hstep, voffA);
        if (wr == 1) PG8_BAR;
        PG8_WAIT_V(4); PG8_BAR;
        PG8_STAGE(PG8_SB(1, 0), cB + kstep, voffB); PG8_STAGE(PG8_SA(1, 0), cA + kstep, voffA); PG8_STAGE(PG8_SB(1, 1), cB + hstep + kstep, voffB);
        PG8_WAIT_V(6); PG8_BAR;
    }
    for (;;) {
        const bool has_next = S.next(ui + 1, nxt);
        const char* nA = has_next ? (const char*)g.A + S.a_off(nxt) + (size_t)nxt.pm * tstep : cA; const char* nB = has_next ? (const char*)g.Bt + S.b_off(nxt) + (size_t)nxt.pn * tstep : cB;
        for (int t = 0; t < nt; t += 2) {
            const bool last = (t == nt - 2);
            const char* a1 = cA + (size_t)(t + 1) * kstep;
            const char* a2 = last ? nA : cA + (size_t)(t + 2) * kstep; const char* b2 = last ? nB : cB + (size_t)(t + 2) * kstep;
            const char* a3 = a2 + kstep; const char* b3 = b2 + kstep;
            if (last && has_next) S.a_ready(nxt);
            if constexpr (SP2) {
            PG8_LDB(B0, 0, 0); PG8_LDB(B1, 0, 1); PG8_SCHED; PG8_LDA(At, 0, 0); PG8_STAGE(PG8_SA(1, 1), a1 + hstep, voffA);
            PG8_WAIT_V(8); PG8_WAIT_L(0); PG8_BAR; PG8_MMA(0, 0, At, B0); PG8_MMA(0, 1, At, B1); PG8_BAR; PG8_SCHED;
            PG8_LDA(At, 0, 1); PG8_STAGE(PG8_SB(0, 0), b2, voffB); PG8_STAGE(PG8_SB(0, 1), b2 + hstep, voffB); PG8_STAGE(PG8_SA(0, 0), a2, voffA);
            PG8_WAIT_V(8); PG8_WAIT_L(0); PG8_BAR; PG8_MMA(1, 0, At, B0); PG8_MMA(1, 1, At, B1); PG8_BAR; PG8_SCHED;
            PG8_LDB(B0, 1, 0); PG8_LDB(B1, 1, 1); PG8_SCHED; PG8_LDA(At, 1, 0); PG8_STAGE(PG8_SA(0, 1), a2 + hstep, voffA);
            PG8_WAIT_V(8); PG8_WAIT_L(0); PG8_BAR; PG8_MMA(0, 0, At, B0); PG8_MMA(0, 1, At, B1); PG8_BAR; PG8_SCHED;
            PG8_LDA(At, 1, 1); PG8_STAGE(PG8_SB(1, 0), b3, voffB); PG8_STAGE(PG8_SB(1, 1), b3 + hstep, voffB); PG8_STAGE(PG8_SA(1, 0), a3, voffA);
            PG8_WAIT_V(8); PG8_WAIT_L(0); PG8_BAR; PG8_MMA(1, 0, At, B0); PG8_MMA(1, 1, At, B1); PG8_BAR; PG8_SCHED;
            } else {
            PG8_LDB(B0, 0, 0); PG8_SCHED; PG8_LDA(At, 0, 0); PG8_STAGE(PG8_SA(1, 1), a1 + hstep, voffA);
            PG8_WAIT_L(8); PG8_BAR; PG8_WAIT_L(0); PG8_MMA(0, 0, At, B0); PG8_BAR; PG8_SCHED;
            PG8_LDB(B1, 0, 1); PG8_STAGE(PG8_SB(0, 0), b2, voffB);
            PG8_BAR; PG8_WAIT_L(0); PG8_MMA(0, 1, At, B1); PG8_BAR;
            PG8_LDA(At, 0, 1); PG8_STAGE(PG8_SA(0, 0), a2, voffA);
            PG8_BAR; PG8_WAIT_L(0); PG8_MMA(1, 0, At, B0); PG8_BAR; PG8_SCHED;
            PG8_STAGE(PG8_SB(0, 1), b2 + hstep, voffB);
            PG8_WAIT_V(6); PG8_BAR; PG8_MMA(1, 1, At, B1); PG8_BAR;
            PG8_LDB(B0, 1, 0); PG8_SCHED; PG8_LDA(At, 1, 0); PG8_STAGE(PG8_SA(0, 1), a2 + hstep, voffA);
            PG8_WAIT_L(8); PG8_BAR; PG8_WAIT_L(0); PG8_MMA(0, 0, At, B0); PG8_BAR; PG8_SCHED;
            PG8_LDB(B1, 1, 1); PG8_STAGE(PG8_SB(1, 0), b3, voffB);
            PG8_BAR; PG8_WAIT_L(0); PG8_MMA(0, 1, At, B1); PG8_BAR;
            PG8_LDA(At, 1, 1); PG8_STAGE(PG8_SA(1, 0), a3, voffA);
            PG8_BAR; PG8_WAIT_L(0); PG8_MMA(1, 0, At, B0); PG8_BAR; PG8_SCHED;
            PG8_STAGE(PG8_SB(1, 1), b3 + hstep, voffB);
            PG8_WAIT_V(6); PG8_BAR; PG8_MMA(1, 1, At, B1); PG8_BAR;
            }
        }
        if constexpr (ALIGN_EPI) { if (wr == 0) PG8_BAR; }
        if constexpr (!Epi::AFTER_DRAIN) { E(acc, cur, wr, wc, fr, fq); S.done(cur); }
        if (!has_next) break;
#pragma unroll
        for (int a = 0; a < 2; ++a)
#pragma unroll
            for (int b = 0; b < 2; ++b)
#pragma unroll
                for (int m = 0; m < 4; ++m)
#pragma unroll
                    for (int n = 0; n < 2; ++n) acc[a][b][m][n] = (f32x4){0.f, 0.f, 0.f, 0.f};
        cur = nxt; cA = nA; cB = nB; ++ui;
        if constexpr (ALIGN_EPI) { if (wr == 1) PG8_BAR; }
    }
    PG8_WAIT_V(0);
    if constexpr (!ALIGN_EPI) { if (wr == 0) PG8_BAR; }
    PG8_BAR;
    if constexpr (Epi::AFTER_DRAIN) { E.fused(acc, cur, wr, wc, fr, fq, lds, wid, lane); S.done(cur); }
#undef PG8_SA
#undef PG8_SB
#undef PG8_STAGE
#undef PG8_LDA
#undef PG8_LDB
#undef PG8_MMA
#undef PG8_WAIT_V
#undef PG8_WAIT_L
#undef PG8_BAR
#undef PG8_SCHED
}
}
#define GAS __attribute__((address_space(1)))
#define LAS __attribute__((address_space(3)))
typedef unsigned short bf16;
typedef unsigned v4u __attribute__((ext_vector_type(4)));
typedef float f32x4 __attribute__((ext_vector_type(4)));
typedef short bf16x8 __attribute__((ext_vector_type(8)));
typedef GAS unsigned gu32;
typedef GAS unsigned long long gu64;
#define RLX_AGENT __ATOMIC_RELAXED, __HIP_MEMORY_SCOPE_AGENT
#define LDS_WAIT() asm volatile("s_waitcnt lgkmcnt(0)" ::: "memory")
#define VM_WAIT() asm volatile("s_waitcnt vmcnt(0)" ::: "memory")
__device__ __forceinline__ unsigned long long rt() { return __builtin_amdgcn_s_memrealtime(); }
__device__ __forceinline__ unsigned f2bf(float f) { unsigned u = __builtin_bit_cast(unsigned, f); return (u + 0x7fffu + ((u >> 16) & 1u)) >> 16; }
__device__ __forceinline__ unsigned pk2(float lo, float hi) { return f2bf(lo) | (f2bf(hi) << 16); }

#define XB_TMO      128
#define XB_XCNT(j)  (256  + 64 * (j))
#define XB_XSUB(j)  (1280 + 64 * (j))
#define XB_XGEN(j)  (2304 + 64 * (j))
#define XB_TOP      3328
#define XB_TOPGEN   3392
#define XCD_BAR_WORDS 3456
#define XB_SPIN_CAP (1u << 18)

__device__ __forceinline__ unsigned xb_ld(unsigned* p)              { return __hip_atomic_load(p, __ATOMIC_RELAXED, __HIP_MEMORY_SCOPE_AGENT); }
__device__ __forceinline__ unsigned xb_add(unsigned* p, unsigned v) { return __hip_atomic_fetch_add(p, v, __ATOMIC_RELAXED, __HIP_MEMORY_SCOPE_AGENT); }
__device__ __forceinline__ unsigned xb_xcc_id() { return (unsigned)__builtin_amdgcn_s_getreg((3 << 11) | 20) & 0xFu; }
#define XB_SPIN(cond, bar) do { unsigned _sp = 0; while (cond) { __builtin_amdgcn_s_sleep(1); \
    if ((++_sp & 255u) == 0u) { if (xb_ld(&(bar)[XB_TMO])) break; if (_sp > XB_SPIN_CAP) { atomicAdd(&(bar)[XB_TMO], 1u); break; } } } } while (0)

struct XcdBarrier {
    unsigned* bar; unsigned x;
    volatile LAS unsigned* st;
};

__device__ __forceinline__ XcdBarrier xcd_barrier_post(unsigned* bar, volatile LAS unsigned* st) {
    XcdBarrier b; b.bar = bar; b.x = xb_xcc_id(); b.st = st;
    if (threadIdx.x == 0) (void)xb_add(&bar[XB_XCNT(b.x)], 1u);
    return b;
}
__device__ __forceinline__ void xcd_barrier_complete(unsigned* bar, unsigned x, unsigned& nloc, unsigned& nx) {
    const unsigned G = gridDim.x * gridDim.y * gridDim.z;
    unsigned sum, cnt, mine, sp = 0u;
    for (;;) {
        sum = 0u; cnt = 0u; mine = 0u;
#pragma unroll
        for (unsigned j = 0; j < 16; ++j) { const unsigned c = xb_ld(&bar[XB_XCNT(j)]); sum += c; cnt += (c > 0u) ? 1u : 0u; mine = (j == x) ? c : mine; }
        if (sum == G) break;
        __builtin_amdgcn_s_sleep(1);
        if ((++sp & 255u) == 0u) { if (xb_ld(&bar[XB_TMO])) break; if (sp > XB_SPIN_CAP) { atomicAdd(&bar[XB_TMO], 1u); break; } }
    }
    nloc = mine > 0u ? mine : 1u; nx = cnt > 0u ? cnt : 1u;
}

__device__ __forceinline__ void xcd_barrier(const XcdBarrier& b) {
    asm volatile("s_waitcnt vmcnt(0)" ::: "memory");
    __syncthreads();
    if (threadIdx.x == 0) {
        unsigned* bar = b.bar;
        __builtin_amdgcn_s_waitcnt(0);
        unsigned nloc = b.st[0], nx = b.st[1];
        if (nloc == 0u) { xcd_barrier_complete(bar, b.x, nloc, nx); b.st[0] = nloc; b.st[1] = nx; }
        const unsigned old = xb_add(&bar[XB_XSUB(b.x)], 1u);
        const unsigned gen = old / nloc;
        if (old + 1u == (gen + 1u) * nloc) {
            __builtin_amdgcn_fence(__ATOMIC_RELEASE, "agent");
            asm volatile("s_waitcnt vmcnt(0)" ::: "memory");
            const unsigned og = xb_add(&bar[XB_TOP], 1u);
            const unsigned tg = og / nx;
            if (og + 1u == (tg + 1u) * nx) xb_add(&bar[XB_TOPGEN], 1u);
            else XB_SPIN(xb_ld(&bar[XB_TOPGEN]) == tg, bar);
            __builtin_amdgcn_fence(__ATOMIC_ACQUIRE, "agent");
            xb_add(&bar[XB_XGEN(b.x)], 1u);
            asm volatile("s_waitcnt vmcnt(0)" ::: "memory");
        } else {
            XB_SPIN(xb_ld(&bar[XB_XGEN(b.x)]) == gen, bar);
            __builtin_amdgcn_fence(__ATOMIC_ACQUIRE, "agent");
            asm volatile("s_waitcnt vmcnt(0)" ::: "memory");
        }
    }
    __syncthreads();
}

constexpr int NTOK = 16384, SEQ = 4096, NBATCH = 4, DM = 1024, NWAVES = 8, NTHREADS = 512;
constexpr int NIN = 8112, NIN_PAD = 8192;
constexpr int FFD = 2816, FFE = 3584, NEXP = 8;
constexpr int MOE_ROWS_MAX = 2 * NTOK + NEXP * 256;
constexpr float RMS_EPS = 1e-6f, LN_EPS_C = 1e-5f;
constexpr float QSCALE = 0.10206207261596577f * 1.4426950408889634f;

constexpr size_t MiB = 1u << 20;
constexpr size_t WS_CTL = 0, CTL_ZERO_BYTES = 1 * MiB;
constexpr size_t WS_WL0 = 1 * MiB, WS_WL_STRIDE = 26 * MiB;
constexpr size_t WO_WIN = 0, WO_WUQ = 16 * MiB, WO_WUKV = 16 * MiB + 768 * 1024, WO_WBR = 17 * MiB + 256 * 1024, WO_WOUT = 23 * MiB + 256 * 1024;
constexpr size_t WS_WGU = 53 * MiB, WS_WDN = 64 * MiB, WS_ROPE = 69 * MiB + 512 * 1024;
constexpr size_t WS_H = 70 * MiB;
constexpr size_t WS_Z = 108 * MiB, WS_XBC = 140 * MiB, WS_MISC = 188 * MiB, WS_U = 204 * MiB, WS_V = 236 * MiB, WS_QRAW = 268 * MiB, WS_KVRAW = 316 * MiB,
                 WS_K = 380 * MiB, WS_VM = 428 * MiB, WS_STATES = 460 * MiB, WS_QLAT = 492 * MiB, WS_AQ = 500 * MiB, WS_AKV = 508 * MiB;
constexpr size_t WS_MERGED = WS_Z, WS_YSSD = WS_V, WS_O = WS_KVRAW, WS_GATES = WS_K;
constexpr size_t WS_TBL = 512 * MiB;
constexpr size_t WS_VSTAT = WS_TBL, WS_DTG = WS_TBL + 1 * MiB, WS_CSG = WS_TBL + 2 * MiB, WS_CDEC = WS_TBL + 3 * MiB, WS_RSTD = WS_TBL + 3 * MiB + 256 * 1024,
                 WS_TOKE = WS_TBL + 3 * MiB + 512 * 1024, WS_TOKP = WS_TBL + 3 * MiB + 768 * 1024, WS_TOKR = WS_TBL + 4 * MiB, WS_TOKW = WS_TBL + 4 * MiB + 256 * 1024, WS_SSQ = WS_TBL + 5 * MiB;
constexpr size_t WS_HID = 108 * MiB;
constexpr size_t WS_WMGU = 1 * MiB, WS_WMDN = 113 * MiB, WS_AG = 169 * MiB, WS_YP = WS_AG, WS_HIDM = 237 * MiB, WS_YPT = WS_WMGU;
constexpr size_t WS_XB2 = 476 * MiB;
constexpr size_t WS_END = 520 * MiB;
static_assert(WS_HIDM + (size_t)MOE_ROWS_MAX * FFE * 2 <= WS_XB2 && WS_GATES + (size_t)NTOK * 3072 * 2 <= WS_XB2 && WS_XB2 + (size_t)NTOK * DM * 2 <= WS_TBL, "XB2");
static_assert(WS_HIDM + (size_t)MOE_ROWS_MAX * FFE * 2 <= WS_TBL && WS_AG + (size_t)MOE_ROWS_MAX * DM * 2 <= WS_HIDM, "MoE overlay");
static_assert(WS_WL0 + 2 * WS_WL_STRIDE <= WS_WGU && WS_WDN + (size_t)DM * FFD * 2 <= WS_ROPE && WS_ROPE + 4096 * 16 * 8 <= WS_H, "weight map");
static_assert(WS_GATES + (size_t)NTOK * 3072 * 2 <= WS_QLAT && WS_AKV + (size_t)NTOK * 128 * 2 <= WS_TBL, "mixer map");
constexpr int CW_TMO = 0, CW_BAR = 4096, CW_CNT = 16384;

constexpr int LDS_BYTES = 147456;
constexpr int LDS_MISC_OFF = 131072 + 8192;

typedef unsigned u32x2 __attribute__((ext_vector_type(2)));
typedef float f32x16 __attribute__((ext_vector_type(16)));
typedef short s16x4 __attribute__((ext_vector_type(4)));
using pg8::pkbf; using pg8::bflo; using pg8::bfhi; using pg8::fsigmoid; using pg8::bf16_t; using pg8::u32x4;

struct Ctx {
    LAS unsigned char* lds; int lane, wave, vcu, G, bx;
    __device__ __forceinline__ int tid() const { return wave * 64 + lane; }
};
__device__ __forceinline__ float lane_xor(float v, int o, int lane) { return __int_as_float(__builtin_amdgcn_ds_bpermute((lane ^ o) << 2, __float_as_int(v))); }
__device__ __forceinline__ float lane_up(float v, int o, int lane) { return __int_as_float(__builtin_amdgcn_ds_bpermute((lane - o) << 2, __float_as_int(v))); }
__device__ __forceinline__ float wave_sum(float v, int lane) {
#pragma unroll
    for (int o = 1; o < 64; o <<= 1) v += lane_xor(v, o, lane);
    return v;
}
__device__ __forceinline__ int crow(int r, int hi) { return (r & 3) + 8 * (r >> 2) + 4 * hi; }
__device__ __forceinline__ s16x4 tr16(LAS const unsigned char* p) { typedef short v4i16_t __attribute__((ext_vector_type(4))); return __builtin_bit_cast(s16x4, __builtin_amdgcn_ds_read_tr16_b64_v4i16((LAS v4i16_t*)p)); }
__device__ __forceinline__ bf16x8 tr_frag(LAS const unsigned char* tile, int pitch, int kb, int c0, int lane) {
    const int g = lane >> 4, hi = g >> 1, q = (lane & 15) >> 2, p = lane & 3;
    LAS const unsigned char* a = tile + (kb + 8 * hi + q) * pitch + (c0 + 16 * (g & 1) + 4 * p) * 2;
    const s16x4 lo = tr16(a), h4 = tr16(a + 4 * pitch);
    return (bf16x8){lo[0], lo[1], lo[2], lo[3], h4[0], h4[1], h4[2], h4[3]};
}
__device__ __forceinline__ bf16x8 tr_frag_acc(LAS const unsigned char* tile, int pitch, int kb, int c0, int lane) {
    const int g = lane >> 4, hi = g >> 1, q = (lane & 15) >> 2, p = lane & 3;
    LAS const unsigned char* a = tile + (kb + 4 * hi + q) * pitch + (c0 + 16 * (g & 1) + 4 * p) * 2;
    const s16x4 lo = tr16(a), h4 = tr16(a + 8 * pitch);
    return (bf16x8){lo[0], lo[1], lo[2], lo[3], h4[0], h4[1], h4[2], h4[3]};
}
__device__ __forceinline__ bf16x8 row_frag(LAS const unsigned char* tile, int pitch, int r0, int kb, int lane) {
    return *(LAS const bf16x8*)(tile + (r0 + (lane & 31)) * pitch + (kb + 8 * (lane >> 5)) * 2);
}
#define MFMA32(a, b, c) __builtin_amdgcn_mfma_f32_32x32x16_bf16((a), (b), (c), 0, 0, 0)
__device__ __forceinline__ f32x16 zero16() { f32x16 z;
#pragma unroll
    for (int i = 0; i < 16; ++i) z[i] = 0.f;
    return z; }
__device__ __forceinline__ void unpack8(const u32x4 w, float (&f)[8]) { f[0] = bflo(w.x); f[1] = bfhi(w.x); f[2] = bflo(w.y); f[3] = bfhi(w.y); f[4] = bflo(w.z); f[5] = bfhi(w.z); f[6] = bflo(w.w); f[7] = bfhi(w.w); }
__device__ __forceinline__ u32x4 pack8(const float (&f)[8]) { u32x4 w; w.x = pkbf(f[0], f[1]); w.y = pkbf(f[2], f[3]); w.z = pkbf(f[4], f[5]); w.w = pkbf(f[6], f[7]); return w; }
__device__ __forceinline__ float silu_f(float x) { return x * fsigmoid(x); }

template <int KIND> __device__ __forceinline__ int wmap(int n) {
    if (KIND == 1) {
        if (n < 2560) return n;
        if (n < 2576) return 2720 + (n - 2560);
        if (n < 3600) return 3072 + (n - 2576);
        if (n < 4624) return 4096 + (n - 3600);
        if (n < 4880) return 2816 + (n - 4624);
        if (n < 5008) return 2560 + (n - 4880);
        if (n < 5040) return 2688 + (n - 5008);
        return 5120 + (n - 5040);
    }
    if (KIND == 2) return (n >> 7) * 256 + (n & 127);
    if (KIND == 3) return (n >> 7) * 256 + 128 + (n & 127);
    return n;
}
constexpr int TR_PITCH = 144, TR_WAVE_BYTES = 64 * TR_PITCH, TR_GROUP_BYTES = 256 * TR_PITCH;
template <int KIND> __device__ __forceinline__ void convert_matrix(const Ctx& F, const float* W, int K, int N, bf16_t* WT, const float* gain = nullptr) {
    LAS unsigned char* scr = F.lds + F.wave * TR_WAVE_BYTES;
    const int lane = F.lane, r = lane >> 4, cq = lane & 15, gw = F.vcu * NWAVES + F.wave, NGW = F.G * NWAVES, nblk = (N + 63) / 64, nitems = (K / 64) * nblk;
#define TR_LOAD(v, item) do { const int kb_ = (item) / nblk, nb_ = (item) % nblk, nc_ = (64 * nb_ + 4 * cq < N) ? 64 * nb_ + 4 * cq : N - 4;     \
        const float* src_ = W + (size_t)(64 * kb_ + 16 * r) * N + nc_; _Pragma("unroll") for (int i_ = 0; i_ < 16; ++i_) v[i_] = *(const f32x4*)(src_ + (size_t)i_ * N); } while (0)
#define TR_STORE(v, item) do { const int kb_ = (item) / nblk, nb_ = (item) % nblk, k0_ = 64 * kb_, n0_ = 64 * nb_; \
        if (gain) { _Pragma("unroll") for (int q_ = 0; q_ < 4; ++q_) { const f32x4 gq_ = *(const f32x4*)(gain + k0_ + 16 * r + 4 * q_); v[4 * q_] = v[4 * q_] * gq_.x; v[4 * q_ + 1] = v[4 * q_ + 1] * gq_.y; v[4 * q_ + 2] = v[4 * q_ + 2] * gq_.z; v[4 * q_ + 3] = v[4 * q_ + 3] * gq_.w; } } \
        _Pragma("unroll") for (int c_ = 0; c_ < 4; ++c_) { u32x4 lo_, hi_; lo_.x = pkbf(v[0][c_], v[1][c_]); lo_.y = pkbf(v[2][c_], v[3][c_]); lo_.z = pkbf(v[4][c_], v[5][c_]); lo_.w = pkbf(v[6][c_], v[7][c_]); \
            hi_.x = pkbf(v[8][c_], v[9][c_]); hi_.y = pkbf(v[10][c_], v[11][c_]); hi_.z = pkbf(v[12][c_], v[13][c_]); hi_.w = pkbf(v[14][c_], v[15][c_]); \
            *(LAS u32x4*)(scr + (4 * cq + c_) * TR_PITCH + 32 * r) = lo_; *(LAS u32x4*)(scr + (4 * cq + c_) * TR_PITCH + 32 * r + 16) = hi_; } \
        LDS_WAIT(); asm volatile("" ::: "memory"); \
        _Pragma("unroll") for (int j_ = 0; j_ < 8; ++j_) { const int n_ = 8 * j_ + (lane >> 3), c_ = lane & 7; const u32x4 o_ = *(LAS const u32x4*)(scr + n_ * TR_PITCH + 16 * c_); \
            if (n0_ + n_ < N) *(u32x4*)(WT + (size_t)wmap<KIND>(n0_ + n_) * K + k0_ + 8 * c_) = o_; } \
        LDS_WAIT(); asm volatile("" ::: "memory"); } while (0)
    int it = gw; if (it >= nitems) return;
    f32x4 va[16], vb[16];
    TR_LOAD(va, it);
#pragma unroll 1
    for (;;) {
        const int nx = it + NGW; const bool hn = nx < nitems;
        if (hn) TR_LOAD(vb, nx);
        TR_STORE(va, it);
        if (!hn) break;
        const int nx2 = nx + NGW; const bool hn2 = nx2 < nitems;
        if (hn2) TR_LOAD(va, nx2);
        TR_STORE(vb, nx);
        if (!hn2) break;
        it = nx2;
    }
#undef TR_LOAD
#undef TR_STORE
}

__device__ __forceinline__ void convert_moe(const Ctx& F, const float* Wg, const float* Wu, const float* Wd, bf16_t* WGU, bf16_t* WDN, LAS unsigned* qhead) {
    LAS unsigned char* scr = F.lds + F.wave * TR_WAVE_BYTES;
    const int lane = F.lane, r = lane >> 4, cq = lane & 15, gw = F.vcu * NWAVES + F.wave, NGW = F.G * NWAVES;
    constexpr int IPM = 896, NITEMS = 24 * IPM;
#define MOE_LOAD(v, item) do { const int mat_ = (item) / IPM, loc_ = (item) % IPM, e_ = mat_ / 3, ty_ = mat_ % 3; const int N_ = (ty_ == 2) ? DM : FFE, nblk_ = N_ / 64; \
        const float* W_ = ((ty_ == 0) ? Wg : (ty_ == 1) ? Wu : Wd) + (size_t)e_ * DM * FFE; const int kb_ = loc_ / nblk_, nb_ = loc_ % nblk_; \
        const float* src_ = W_ + (size_t)(64 * kb_ + 16 * r) * N_ + 64 * nb_ + 4 * cq; _Pragma("unroll") for (int i_ = 0; i_ < 16; ++i_) v[i_] = __builtin_nontemporal_load((const f32x4*)(src_ + (size_t)i_ * N_)); } while (0)
#define MOE_STORE(v, item) do { const int mat_ = (item) / IPM, loc_ = (item) % IPM, e_ = mat_ / 3, ty_ = mat_ % 3; const int N_ = (ty_ == 2) ? DM : FFE, K_ = (ty_ == 2) ? FFE : DM, nblk_ = N_ / 64; \
        const int kb_ = loc_ / nblk_, nb_ = loc_ % nblk_, k0_ = 64 * kb_, n0_ = 64 * nb_; \
        _Pragma("unroll") for (int c_ = 0; c_ < 4; ++c_) { u32x4 lo_, hi_; lo_.x = pkbf(v[0][c_], v[1][c_]); lo_.y = pkbf(v[2][c_], v[3][c_]); lo_.z = pkbf(v[4][c_], v[5][c_]); lo_.w = pkbf(v[6][c_], v[7][c_]); \
            hi_.x = pkbf(v[8][c_], v[9][c_]); hi_.y = pkbf(v[10][c_], v[11][c_]); hi_.z = pkbf(v[12][c_], v[13][c_]); hi_.w = pkbf(v[14][c_], v[15][c_]); \
            *(LAS u32x4*)(scr + (4 * cq + c_) * TR_PITCH + 32 * r) = lo_; *(LAS u32x4*)(scr + (4 * cq + c_) * TR_PITCH + 32 * r + 16) = hi_; } \
        LDS_WAIT(); asm volatile("" ::: "memory"); \
        bf16_t* D_ = (ty_ == 2) ? WDN + (size_t)e_ * DM * FFE : WGU + (size_t)e_ * 2 * FFE * DM; \
        _Pragma("unroll") for (int j_ = 0; j_ < 8; ++j_) { const int n_ = n0_ + 8 * j_ + (lane >> 3), c_ = lane & 7; const u32x4 o_ = *(LAS const u32x4*)(scr + (8 * j_ + (lane >> 3)) * TR_PITCH + 16 * c_); \
            const int row_ = (ty_ == 2) ? n_ : ((n_ >> 7) * 256 + (ty_ == 1 ? 128 : 0) + (n_ & 127)); \
            *(u32x4*)(D_ + (size_t)row_ * K_ + k0_ + 8 * c_) = o_; } \
        LDS_WAIT(); asm volatile("" ::: "memory"); } while (0)
#define MOE_GRAB(dst) do { unsigned i_ = 0u; if (lane == 0) i_ = __hip_atomic_fetch_add(qhead, 1u, __ATOMIC_RELAXED, __HIP_MEMORY_SCOPE_WORKGROUP); i_ = (unsigned)__builtin_amdgcn_readfirstlane((int)i_); \
        dst = (int)(8u * (unsigned)F.vcu + (i_ & 7u) + (i_ >> 3) * (unsigned)NGW); if (dst >= NITEMS) dst = NITEMS; } while (0)
    (void)gw; int it, nx; MOE_GRAB(it); if (it >= NITEMS) return;
    f32x4 va[16], vb[16];
    MOE_LOAD(va, it);
#pragma unroll 1
    for (;;) {
        MOE_GRAB(nx); { const int pf = nx < NITEMS ? nx : it; MOE_LOAD(vb, pf); }
        MOE_STORE(va, it);
        if (nx >= NITEMS) break;
        MOE_GRAB(it); { const int pf = it < NITEMS ? it : nx; MOE_LOAD(va, pf); }
        MOE_STORE(vb, nx);
        if (it >= NITEMS) break;
    }
#undef MOE_GRAB
#undef MOE_LOAD
#undef MOE_STORE
}

struct ConvJob { const float* src; bf16_t* dst; const float* gain; int K, N, kind, start; };
constexpr int CJ_MAX = 20, CJ_OFF = 8 * TR_WAVE_BYTES;
__device__ __forceinline__ void convert_jobs(const Ctx& F, int njobs) {
    LAS unsigned char* scr = F.lds + F.wave * TR_WAVE_BYTES; const LAS ConvJob* tab = (const LAS ConvJob*)(F.lds + CJ_OFF);
    const int lane = F.lane, r = lane >> 4, cq = lane & 15, gw = F.vcu * NWAVES + F.wave, NGW = F.G * NWAVES;
    const int nitems = __builtin_amdgcn_readfirstlane(tab[njobs].start);
#define CJ_FIND(item, jb, loc) int jb = 0; _Pragma("unroll 1") for (int q_ = 1; q_ < njobs; ++q_) { if (__builtin_amdgcn_readfirstlane(tab[q_].start) <= (item)) jb = q_; } const int loc = (item) - __builtin_amdgcn_readfirstlane(tab[jb].start)
#define CJ_LOAD(v, item) do { CJ_FIND(item, jb_, loc_); const int N_ = __builtin_amdgcn_readfirstlane(tab[jb_].N), nblk_ = (N_ + 63) / 64, kb_ = loc_ / nblk_, nb_ = loc_ % nblk_; \
        const GAS float* W_ = (const GAS float*)tab[jb_].src; const int nc_ = (64 * nb_ + 4 * cq < N_) ? 64 * nb_ + 4 * cq : N_ - 4; \
        const GAS float* src_ = W_ + (size_t)(64 * kb_ + 16 * r) * N_ + nc_; _Pragma("unroll") for (int i_ = 0; i_ < 16; ++i_) v[i_] = __builtin_nontemporal_load((const GAS f32x4*)(src_ + (size_t)i_ * N_)); } while (0)
#define CJ_STORE(v, item) do { CJ_FIND(item, jb_, loc_); const int N_ = __builtin_amdgcn_readfirstlane(tab[jb_].N), K_ = __builtin_amdgcn_readfirstlane(tab[jb_].K), kind_ = __builtin_amdgcn_readfirstlane(tab[jb_].kind); \
        const int nblk_ = (N_ + 63) / 64, kb_ = loc_ / nblk_, nb_ = loc_ % nblk_, k0_ = 64 * kb_, n0_ = 64 * nb_; const GAS float* gain_ = (const GAS float*)tab[jb_].gain; GAS bf16_t* D_ = (GAS bf16_t*)tab[jb_].dst; \
        if (gain_) { _Pragma("unroll") for (int q_ = 0; q_ < 4; ++q_) { const f32x4 gq_ = *(const GAS f32x4*)(gain_ + k0_ + 16 * r + 4 * q_); v[4 * q_] = v[4 * q_] * gq_.x; v[4 * q_ + 1] = v[4 * q_ + 1] * gq_.y; v[4 * q_ + 2] = v[4 * q_ + 2] * gq_.z; v[4 * q_ + 3] = v[4 * q_ + 3] * gq_.w; } } \
        _Pragma("unroll") for (int c_ = 0; c_ < 4; ++c_) { u32x4 lo_, hi_; lo_.x = pkbf(v[0][c_], v[1][c_]); lo_.y = pkbf(v[2][c_], v[3][c_]); lo_.z = pkbf(v[4][c_], v[5][c_]); lo_.w = pkbf(v[6][c_], v[7][c_]); \
            hi_.x = pkbf(v[8][c_], v[9][c_]); hi_.y = pkbf(v[10][c_], v[11][c_]); hi_.z = pkbf(v[12][c_], v[13][c_]); hi_.w = pkbf(v[14][c_], v[15][c_]); \
            *(LAS u32x4*)(scr + (4 * cq + c_) * TR_PITCH + 32 * r) = lo_; *(LAS u32x4*)(scr + (4 * cq + c_) * TR_PITCH + 32 * r + 16) = hi_; } \
        LDS_WAIT(); asm volatile("" ::: "memory"); \
        _Pragma("unroll") for (int j_ = 0; j_ < 8; ++j_) { const int n_ = n0_ + 8 * j_ + (lane >> 3), c_ = lane & 7; const u32x4 o_ = *(LAS const u32x4*)(scr + (8 * j_ + (lane >> 3)) * TR_PITCH + 16 * c_); \
            const int row_ = (kind_ == 1) ? wmap<1>(n_) : (kind_ == 2) ? wmap<2>(n_) : (kind_ == 3) ? wmap<3>(n_) : n_; \
            if (n_ < N_) *(GAS u32x4*)(D_ + (size_t)row_ * K_ + k0_ + 8 * c_) = o_; } \
        LDS_WAIT(); asm volatile("" ::: "memory"); } while (0)
    int it = gw; if (it >= nitems) return;
    f32x4 va[16], vb[16];
    CJ_LOAD(va, it);
#pragma unroll 1
    for (;;) {
        const int nx = it + NGW; { const int pf = nx < nitems ? nx : it; CJ_LOAD(vb, pf); }
        CJ_STORE(va, it);
        if (nx >= nitems) break;
        const int nx2 = nx + NGW; { const int pf = nx2 < nitems ? nx2 : nx; CJ_LOAD(va, pf); }
        CJ_STORE(vb, nx);
        if (nx2 >= nitems) break;
        it = nx2;
    }
#undef CJ_FIND
#undef CJ_LOAD
#undef CJ_STORE
}

template <int MODE> __device__ __forceinline__ void convert_probe(const Ctx& F, const float* W, int K, int N, bf16_t* WT) {
    const int grp = F.wave >> 2, j = F.wave & 3, lane = F.lane, gl = (F.wave & 3) * 64 + lane;
    LAS unsigned char* scr = F.lds + grp * TR_GROUP_BYTES;
    const int nblk = (N + 255) / 256, nitems = (K / 64) * nblk, NG = F.G * 2;
    const int iters = (nitems + NG - 1) / NG;
#pragma unroll 1
    for (int itn = 0; itn < iters; ++itn) {
        const int item = (F.vcu * 2 + grp) + itn * NG; const bool valid = item < nitems;
        const int kb = valid ? item / nblk : 0, nb = valid ? item % nblk : 0, k0 = 64 * kb, n0 = 256 * nb;
        if (valid && MODE != 3) {
            const int ncl = (n0 + 4 * lane < N) ? n0 + 4 * lane : N - 4;
            const float* src = W + (size_t)(k0 + 16 * j) * N + ncl;
            f32x4 v[16];
#pragma unroll
            for (int i = 0; i < 16; ++i) v[i] = *(const f32x4*)(src + (size_t)i * N);
            if (MODE == 2) {
#pragma unroll
                for (int i = 0; i < 16; ++i) asm volatile("" :: "v"(v[i]));
            } else {
#pragma unroll
            for (int c = 0; c < 4; ++c) {
                u32x4 lo, hi; lo.x = pkbf(v[0][c], v[1][c]); lo.y = pkbf(v[2][c], v[3][c]); lo.z = pkbf(v[4][c], v[5][c]); lo.w = pkbf(v[6][c], v[7][c]);
                hi.x = pkbf(v[8][c], v[9][c]); hi.y = pkbf(v[10][c], v[11][c]); hi.z = pkbf(v[12][c], v[13][c]); hi.w = pkbf(v[14][c], v[15][c]);
                *(LAS u32x4*)(scr + (4 * lane + c) * TR_PITCH + 32 * j) = lo; *(LAS u32x4*)(scr + (4 * lane + c) * TR_PITCH + 32 * j + 16) = hi;
            } }
        }
        __syncthreads();
        if (valid && MODE != 2) {
#pragma unroll
            for (int q = 0; q < 8; ++q) { const int n = 32 * q + (gl >> 3), c = gl & 7; const u32x4 o = *(LAS const u32x4*)(scr + n * TR_PITCH + 16 * c);
                if (MODE == 1) *(u32x4*)(WT + (size_t)item * 16384 + (size_t)(q * 256 + gl) * 8) = o;
                else if (n0 + n < N) *(u32x4*)(WT + (size_t)(n0 + n) * K + k0 + 8 * c) = o; }
        }
        __syncthreads();
    }
}

__device__ __forceinline__ void rmsnorm_rows(const Ctx& F, const float* x, const float* g, bf16_t* H, int n_extra) {
    constexpr int SKIP = 3;
    const int gw = F.vcu * NWAVES + F.wave, NGW = F.G * NWAVES, per = NTOK / NGW;
    int T = (gw < NTOK) ? (NTOK - 1 - gw) / NGW + 1 : 0, mx = -1;
    if (NTOK % NGW == 0 && per > SKIP && n_extra > 0 && n_extra * (1 + SKIP) <= NGW) {
        if (gw < n_extra) T = per - SKIP;
        else if (gw < n_extra * (1 + SKIP)) { const int e = gw - n_extra; mx = (e % n_extra) + (per - SKIP + e / n_extra) * NGW; } }
    const int total = T + (mx >= 0 ? 1 : 0);
    if (total == 0) return;
    f32x4 gv[4];
#pragma unroll
    for (int j = 0; j < 4; ++j) gv[j] = ((const f32x4*)g)[F.lane + 64 * j];
    f32x4 vn[4];
    { const int m0 = (0 < T) ? gw : mx; const f32x4* xr = (const f32x4*)(x + (size_t)m0 * DM) + F.lane;
#pragma unroll
        for (int j = 0; j < 4; ++j) vn[j] = xr[64 * j]; }
#pragma unroll 1
    for (int t = 0; t < total; ++t) {
        const int m = (t < T) ? gw + t * NGW : mx;
        f32x4 v[4]; float s = 0.f;
#pragma unroll
        for (int j = 0; j < 4; ++j) { v[j] = vn[j]; s += (v[j].x * v[j].x + v[j].y * v[j].y) + (v[j].z * v[j].z + v[j].w * v[j].w); }
        { const int tn = (t + 1 < total) ? t + 1 : t; const int pf = (tn < T) ? gw + tn * NGW : mx; const f32x4* xr = (const f32x4*)(x + (size_t)pf * DM) + F.lane;
#pragma unroll
          for (int j = 0; j < 4; ++j) vn[j] = xr[64 * j]; }
        const float rstd = 1.0f / sqrtf(wave_sum(s, F.lane) * (1.0f / DM) + RMS_EPS);
        u32x2* o = (u32x2*)(H + (size_t)m * DM) + F.lane;
#pragma unroll
        for (int j = 0; j < 4; ++j) { u32x2 w; w.x = pkbf(v[j].x * rstd * gv[j].x, v[j].y * rstd * gv[j].y); w.y = pkbf(v[j].z * rstd * gv[j].z, v[j].w * rstd * gv[j].w); o[64 * j] = w; }
    }
}
__device__ __forceinline__ void mixer_rowpass(const Ctx& F, const bf16_t* QLAT, const float* MISC, const bf16_t* V, const float* qg, const float* kvg, bf16_t* AQ, bf16_t* AKV, float* VSTAT) {
    const int gw = F.vcu * NWAVES + F.wave, NGW = F.G * NWAVES, lane = F.lane;
    const f32x4 gq = ((const f32x4*)qg)[lane]; const float gk0 = kvg[2 * lane], gk1 = kvg[2 * lane + 1];
#define RP_LOAD(Q_, A_, B_, W0_, W1_, m_) do { Q_ = ((const u32x2*)(QLAT + (size_t)(m_) * 256))[lane]; { const pg8::f32x2 ab_ = *(const pg8::f32x2*)(MISC + (size_t)(m_) * 256 + 2 * lane); A_ = ab_.x; B_ = ab_.y; } \
        W0_ = ((const u32x4*)(V + (size_t)(m_) * 1024))[lane]; W1_ = ((const u32x4*)(V + (size_t)(m_) * 1024))[64 + lane]; } while (0)
#define RP_DO(Q_, A_, B_, W0_, W1_, m_) do { \
        { const float a = bflo(Q_.x), b = bfhi(Q_.x), c = bflo(Q_.y), d = bfhi(Q_.y); \
          const float rs = 1.0f / sqrtf(wave_sum((a * a + b * b) + (c * c + d * d), lane) * (1.0f / 256.0f) + RMS_EPS); \
          u32x2 o; o.x = pkbf(a * rs * gq.x, b * rs * gq.y); o.y = pkbf(c * rs * gq.z, d * rs * gq.w); ((u32x2*)(AQ + (size_t)(m_) * 256))[lane] = o; } \
        { const float rs = 1.0f / sqrtf(wave_sum(A_ * A_ + B_ * B_, lane) * (1.0f / 128.0f) + RMS_EPS); ((unsigned*)(AKV + (size_t)(m_) * 128))[lane] = pkbf(A_ * rs * gk0, B_ * rs * gk1); } \
        { float f[16]; { float t[8]; unpack8(W0_, t); _Pragma("unroll") for (int i = 0; i < 8; ++i) f[i] = t[i]; unpack8(W1_, t); _Pragma("unroll") for (int i = 0; i < 8; ++i) f[8 + i] = t[i]; } \
          float s = 0.f, q = 0.f; _Pragma("unroll") for (int i = 0; i < 16; ++i) { s += f[i]; q += f[i] * f[i]; }        \
          const float mean = wave_sum(s, lane) * (1.0f / 1024.0f), ex2 = wave_sum(q, lane) * (1.0f / 1024.0f); \
          const float var = ex2 - mean * mean; const float rstd = 1.0f / sqrtf((var > 0.f ? var : 0.f) + LN_EPS_C); \
          if (lane == 0) { VSTAT[2 * (m_)] = mean; VSTAT[2 * (m_) + 1] = rstd; } } } while (0)
    int m = gw; if (m >= NTOK) return;
    u32x2 qa, qb; float aa, ab, ba, bb; u32x4 wa0, wa1, wb0, wb1;
    RP_LOAD(qa, aa, ab, wa0, wa1, m);
#pragma unroll 1
    for (;;) {
        const int n1 = m + NGW; { const int pf = n1 < NTOK ? n1 : m; RP_LOAD(qb, ba, bb, wb0, wb1, pf); }
        RP_DO(qa, aa, ab, wa0, wa1, m);
        if (n1 >= NTOK) break;
        const int n2 = n1 + NGW; { const int pf = n2 < NTOK ? n2 : n1; RP_LOAD(qa, aa, ab, wa0, wa1, pf); }
        RP_DO(qb, ba, bb, wb0, wb1, n1);
        if (n2 >= NTOK) break;
        m = n2;
    }
#undef RP_LOAD
#undef RP_DO
}
__device__ __forceinline__ void qk_finalize(const Ctx& F, const bf16_t* KNOPE, const float* MISC, const float* khg, const float* ROPE, bf16_t* Kout) {
    const int gw = F.vcu * NWAVES + F.wave, NGW = F.G * NWAVES, lane = F.lane, h = lane >> 2, j = lane & 3;
    float gkn[16], gk1[4], gk2[4];
#pragma unroll
    for (int i = 0; i < 16; ++i) gkn[i] = khg[(i < 8 ? 8 * j : 32 + 8 * j - 8) + i];
#pragma unroll
    for (int i = 0; i < 4; ++i) { gk1[i] = khg[64 + 4 * j + i]; gk2[i] = khg[80 + 4 * j + i]; }
    struct Tok { u32x4 kn0, kn1; f32x4 p1, p2, c0, c1; };
#define QK_LOAD(T_, m_) do { const bf16_t* kvb_ = KNOPE + (size_t)(m_) * 1024 + h * 64; const int pos_ = (m_) & (SEQ - 1); \
        T_.kn0 = *(const u32x4*)(kvb_ + 8 * j); T_.kn1 = *(const u32x4*)(kvb_ + 32 + 8 * j); \
        T_.p1 = *(const f32x4*)(MISC + (size_t)(m_) * 256 + 128 + 4 * j); T_.p2 = *(const f32x4*)(MISC + (size_t)(m_) * 256 + 144 + 4 * j); \
        T_.c0 = *(const f32x4*)(ROPE + (size_t)pos_ * 32 + 8 * j); T_.c1 = *(const f32x4*)(ROPE + (size_t)pos_ * 32 + 8 * j + 4); } while (0)
#define QK_DO(T_, m_) do { \
        const float cc[4] = {T_.c0.x, T_.c0.z, T_.c1.x, T_.c1.z}, ss[4] = {T_.c0.y, T_.c0.w, T_.c1.y, T_.c1.w}; \
        {   float n[16], x1[4], x2[4]; { float t[8]; unpack8(T_.kn0, t); _Pragma("unroll") for (int i = 0; i < 8; ++i) n[i] = t[i]; unpack8(T_.kn1, t); _Pragma("unroll") for (int i = 0; i < 8; ++i) n[8 + i] = t[i]; } \
            x1[0] = T_.p1.x; x1[1] = T_.p1.y; x1[2] = T_.p1.z; x1[3] = T_.p1.w; x2[0] = T_.p2.x; x2[1] = T_.p2.y; x2[2] = T_.p2.z; x2[3] = T_.p2.w; \
            float s = 0.f; _Pragma("unroll") for (int i = 0; i < 16; ++i) s += n[i] * n[i]; _Pragma("unroll") for (int i = 0; i < 4; ++i) s += x1[i] * x1[i] + x2[i] * x2[i]; \
            s += lane_xor(s, 1, lane); s += lane_xor(s, 2, lane); \
            const float rs = 1.0f / sqrtf(s * (1.0f / 96.0f) + RMS_EPS); \
            _Pragma("unroll") for (int i = 0; i < 16; ++i) n[i] *= rs * gkn[i]; \
            float o1[4], o2[4]; _Pragma("unroll") for (int i = 0; i < 4; ++i) { const float a = x1[i] * rs * gk1[i], b = x2[i] * rs * gk2[i]; o1[i] = a * cc[i] - b * ss[i]; o2[i] = a * ss[i] + b * cc[i]; } \
            bf16_t* kb = Kout + (size_t)(m_) * 1536 + h * 96; \
            { float t[8]; _Pragma("unroll") for (int i = 0; i < 8; ++i) t[i] = n[i]; *(u32x4*)(kb + 8 * j) = pack8(t); _Pragma("unroll") for (int i = 0; i < 8; ++i) t[i] = n[8 + i]; *(u32x4*)(kb + 32 + 8 * j) = pack8(t); } \
            { u32x2 a, b; a.x = pkbf(o1[0], o1[1]); a.y = pkbf(o1[2], o1[3]); b.x = pkbf(o2[0], o2[1]); b.y = pkbf(o2[2], o2[3]); *(u32x2*)(kb + 64 + 4 * j) = a; *(u32x2*)(kb + 80 + 4 * j) = b; } } } while (0)
    int m = gw; if (m >= NTOK) return;
    Tok ta, tb;
    QK_LOAD(ta, m);
#pragma unroll 1
    for (;;) {
        const int n1 = m + NGW; { const int pf = n1 < NTOK ? n1 : m; QK_LOAD(tb, pf); }
        QK_DO(ta, m);
        if (n1 >= NTOK) break;
        const int n2 = n1 + NGW; { const int pf = n2 < NTOK ? n2 : n1; QK_LOAD(ta, pf); }
        QK_DO(tb, n1);
        if (n2 >= NTOK) break;
        m = n2;
    }
#undef QK_LOAD
#undef QK_DO
}

template <int R> __device__ __forceinline__ void conv8(const bf16_t* xb, int s0, int ch0, const float* cw, const float* cb, float (&out)[R][8]) {
    float w[4][8], bias[8];
#pragma unroll
    for (int j = 0; j < 4; ++j) { const f32x4 a = *(const f32x4*)(cw + j * 1536 + ch0), b = *(const f32x4*)(cw + j * 1536 + ch0 + 4); w[j][0] = a.x; w[j][1] = a.y; w[j][2] = a.z; w[j][3] = a.w; w[j][4] = b.x; w[j][5] = b.y; w[j][6] = b.z; w[j][7] = b.w; }
    { const f32x4 a = *(const f32x4*)(cb + ch0), b = *(const f32x4*)(cb + ch0 + 4); bias[0] = a.x; bias[1] = a.y; bias[2] = a.z; bias[3] = a.w; bias[4] = b.x; bias[5] = b.y; bias[6] = b.z; bias[7] = b.w; }
    float x[R + 3][8];
#pragma unroll
    for (int i = 0; i < R + 3; ++i) { const int s = s0 - 3 + i; u32x4 raw = (u32x4){0u, 0u, 0u, 0u}; if (s >= 0) raw = *(const u32x4*)(xb + (size_t)s * 1536 + ch0); unpack8(raw, x[i]); }
#pragma unroll
    for (int r = 0; r < R; ++r)
#pragma unroll
        for (int e = 0; e < 8; ++e) { float a = bias[e];
#pragma unroll
            for (int j = 0; j < 4; ++j) a += w[j][e] * x[r + j][e];
            out[r][e] = silu_f(a); }
}
constexpr int SA_BS = 0, SA_XW = 40960, SA_CS = 65536, SA_DT = 69632, SA_WC = 73728, SA_ST = 83968;
constexpr int SC_CS_T = 0, SC_BM = 34816, SC_XS = 69632, SC_PV = 94208, SC_ZS = 111616, SC_CS = 130048, SC_DT = 134144, SC_SSQ = 138240;
__device__ __forceinline__ void ssd_pass_a(const Ctx& F, const bf16_t* XBC, const float* MISC, const float* conv_w, const float* conv_b, const float* dt_bias, const float* a_log,
                                           bf16_t* STATES, float* CSG, float* DTG, float* CDEC, bf16_t* XC) {
    const int tid = F.tid(), lane = F.lane, w = F.wave, r32 = lane & 31, hi = lane >> 5;
    LAS unsigned char* Bs = F.lds + SA_BS; LAS unsigned char* Xw = F.lds + SA_XW; LAS float* csl = (LAS float*)(F.lds + SA_CS); LAS float* dtl = (LAS float*)(F.lds + SA_DT); LAS float* wcl = (LAS float*)(F.lds + SA_WC); LAS unsigned char* Sl = F.lds + SA_ST;
#pragma unroll 1
    for (int item = F.vcu; item < NBATCH * 32 * 2; item += F.G) {
        const int b = item >> 6, c = (item >> 1) & 31, g = item & 1;
        const bf16_t* xb = XBC + (size_t)b * SEQ * 1536; const int s_base = c * 128; const size_t tok0 = (size_t)b * SEQ + s_base;
#pragma unroll
        for (int j = 0; j < 5; ++j) wcl[j * 512 + tid] = (j < 4) ? conv_w[j * 1536 + 512 * g + tid] : conv_b[512 * g + tid];
        const int cc = tid & 7, pr = tid >> 3;
        u32x4 rx[5];
#define PA_FETCH(hh_) do { _Pragma("unroll") for (int i_ = 0; i_ < 5; ++i_) { int s_ = s_base + 2 * pr - 3 + i_; s_ = s_ < 0 ? 0 : s_; rx[i_] = *(const u32x4*)(xb + (size_t)s_ * 1536 + 64 * (8 * g + (hh_)) + 8 * cc); } } while (0)
        PA_FETCH(0);
        {
            const int cc = tid & 15, pr = tid >> 4; float o[4][8]; conv8<4>(xb, s_base + 4 * pr, 1024 + g * 128 + 8 * cc, conv_w, conv_b, o);
#pragma unroll
            for (int r = 0; r < 4; ++r) *(LAS u32x4*)(Bs + (4 * pr + r) * 320 + cc * 16) = pack8(o[r]);
        }
        {
            const int h = 8 * g + w; const float a = -__expf(a_log[h]), bias = dt_bias[h];
            float d0 = MISC[(tok0 + 2 * lane) * 256 + 160 + h] + bias, d1 = MISC[(tok0 + 2 * lane + 1) * 256 + 160 + h] + bias;
            d0 = d0 > 20.f ? d0 : __logf(1.0f + __expf(d0)); d1 = d1 > 20.f ? d1 : __logf(1.0f + __expf(d1));
            const float v0 = d0 * a, v1 = d1 * a; float inc = v0 + v1;
#pragma unroll
            for (int o = 1; o < 64; o <<= 1) { const float t = lane_up(inc, o, lane); if (lane >= o) inc += t; }
            const float c1 = inc, c0 = inc - v1;
            csl[w * 128 + 2 * lane] = c0; csl[w * 128 + 2 * lane + 1] = c1; dtl[w * 128 + 2 * lane] = d0; dtl[w * 128 + 2 * lane + 1] = d1;
            if (lane == 63) CDEC[(b * 32 + c) * 16 + h] = __expf(c1);
        }
        __syncthreads();
#pragma unroll
        for (int i = 0; i < 2; ++i) { const int id = tid + 512 * i, l = id >> 3, hq = id & 7; CSG[(tok0 + l) * 16 + 8 * g + hq] = csl[hq * 128 + l]; DTG[(tok0 + l) * 16 + 8 * g + hq] = dtl[hq * 128 + l]; }
#pragma unroll 1
#define PA_FLUSH(h_) do { bf16_t* st_ = STATES + ((size_t)((b * 32 + c) * 16 + (h_)) * 64) * 128; _Pragma("unroll") for (int i_ = 0; i_ < 2; ++i_) { const int id_ = tid + 512 * i_; \
            *(u32x4*)(st_ + (size_t)(id_ >> 4) * 128 + (id_ & 15) * 8) = *(LAS const u32x4*)(Sl + (id_ >> 4) * 272 + (id_ & 15) * 16); } } while (0)
        for (int hh = 0; hh < 8; ++hh) {
            const int h = 8 * g + hh;
            if (hh > 0) PA_FLUSH(h - 1);
            {
                float o[2][8];
                { float wv[4][8], bias[8]; const int ch0 = 64 * h + 8 * cc;
#pragma unroll
                  for (int j = 0; j < 4; ++j) { const f32x4 wa = *(LAS const f32x4*)(wcl + j * 512 + 64 * hh + 8 * cc), wb = *(LAS const f32x4*)(wcl + j * 512 + 64 * hh + 8 * cc + 4); wv[j][0] = wa.x; wv[j][1] = wa.y; wv[j][2] = wa.z; wv[j][3] = wa.w; wv[j][4] = wb.x; wv[j][5] = wb.y; wv[j][6] = wb.z; wv[j][7] = wb.w; }
                  { const f32x4 wa = *(LAS const f32x4*)(wcl + 2048 + 64 * hh + 8 * cc), wb = *(LAS const f32x4*)(wcl + 2048 + 64 * hh + 8 * cc + 4); bias[0] = wa.x; bias[1] = wa.y; bias[2] = wa.z; bias[3] = wa.w; bias[4] = wb.x; bias[5] = wb.y; bias[6] = wb.z; bias[7] = wb.w; }
                  float xr[5][8];
#pragma unroll
                  for (int i = 0; i < 5; ++i) { u32x4 raw = rx[i]; if (s_base + 2 * pr - 3 + i < 0) raw = (u32x4){0u, 0u, 0u, 0u}; unpack8(raw, xr[i]); }
#pragma unroll
                  for (int r = 0; r < 2; ++r)
#pragma unroll
                      for (int e = 0; e < 8; ++e) { float acc = bias[e];
#pragma unroll
                          for (int j = 0; j < 4; ++j) acc += wv[j][e] * xr[r + j][e];
                          o[r][e] = silu_f(acc); } }
                const float ce = csl[hh * 128 + 127];
#pragma unroll
                for (int r = 0; r < 2; ++r) { const int l = 2 * pr + r; const float sc = dtl[hh * 128 + l] * __expf(ce - csl[hh * 128 + l]);
                    *(u32x4*)(XC + (tok0 + l) * 1024 + 64 * h + 8 * cc) = pack8(o[r]);
#pragma unroll
                    for (int e = 0; e < 8; ++e) o[r][e] *= sc;
                    *(LAS u32x4*)(Xw + l * 192 + cc * 16) = pack8(o[r]); }
            }
            __syncthreads();
            { const int hn = hh < 7 ? hh + 1 : 7; PA_FETCH(hn); }
            {   const int tp = w >> 2, tn = w & 3; f32x16 acc = zero16();
#pragma unroll
                for (int ks = 0; ks < 8; ++ks) acc = MFMA32(tr_frag(Bs, 320, 16 * ks, 32 * tn, lane), tr_frag(Xw, 192, 16 * ks, 32 * tp, lane), acc);
#pragma unroll
                for (int q = 0; q < 4; ++q) { u32x2 o; o.x = pkbf(acc[4 * q], acc[4 * q + 1]); o.y = pkbf(acc[4 * q + 2], acc[4 * q + 3]); *(LAS u32x2*)(Sl + (32 * tp + r32) * 272 + (32 * tn + 8 * q + 4 * hi) * 2) = o; }
            }
            __syncthreads();
        }
        PA_FLUSH(8 * g + 7);
#undef PA_FLUSH
        __syncthreads();
    }
}
#undef PA_FETCH
__device__ __forceinline__ void ssd_scan(const Ctx& F, bf16_t* STATES, const float* CDEC) {
    const bool half = (F.G == 256); if (half && F.bx < 128) return;
    const int gt = (half ? F.bx - 128 : F.vcu) * NTHREADS + F.tid(), NGT = (half ? 128 : F.G) * NTHREADS;
    for (int v = gt; v < NBATCH * 16 * 64 * 16; v += NGT) {
        const int bh = v >> 10, b = bh >> 4, h = bh & 15, rem = v & 1023;
        float carry[8];
#pragma unroll
        for (int i = 0; i < 8; ++i) carry[i] = 0.f;
        u32x4* p0 = (u32x4*)(STATES + ((size_t)(b * 32 * 16 + h) * 64) * 128 + (size_t)rem * 8);
        const float* d0 = CDEC + b * 32 * 16 + h;
        {   u32x4 s[32]; float dec[32];
            u32x4* ps = p0; asm volatile("" : "+v"(ps));
#pragma unroll
            for (int j = 0; j < 32; ++j) { s[j] = p0[(size_t)j * 16384]; dec[j] = d0[j * 16]; }
#pragma unroll
            for (int j = 0; j < 32; ++j) { float f[8]; unpack8(s[j], f); *ps = pack8(carry); ps += 16384; asm volatile("" : "+v"(ps));
#pragma unroll
                for (int i = 0; i < 8; ++i) carry[i] = carry[i] * dec[j] + f[i]; }
        }
    }
}
__device__ __forceinline__ void ssd_pass_c(const Ctx& F, const bf16_t* XBC, const bf16_t* STATES, const float* CSG, const float* DTG, const bf16_t* Z, const float* conv_w, const float* conv_b,
                                           const float* d_skip, const bf16_t* XC, bf16_t* YSSD) {
    const int tid = F.tid(), lane = F.lane, w = F.wave, r32 = lane & 31, hi = lane >> 5;
    LAS unsigned char* Cs = F.lds + SC_CS_T; LAS unsigned char* Bm = F.lds + SC_BM; LAS unsigned char* Xs = F.lds + SC_XS; LAS unsigned char* PVs = F.lds + SC_PV;
    LAS float* csl = (LAS float*)(F.lds + SC_CS); LAS float* dtl = (LAS float*)(F.lds + SC_DT); LAS float* ssql = (LAS float*)(F.lds + SC_SSQ); LAS unsigned char* Zs = F.lds + SC_ZS;
#pragma unroll 1
    for (int item = F.vcu; item < NBATCH * 32 * 2; item += F.G) {
        const int b = item >> 6, c = (item >> 1) & 31, g = item & 1;
        const bf16_t* xb = XBC + (size_t)b * SEQ * 1536; const int s_base = c * 128; const size_t tok0 = (size_t)b * SEQ + s_base;
        u32x4 px[2], ps[2], pz[2]; float csr[2], dtr[2];
#define PC_FETCH(hh_) do { const int h_ = 8 * g + (hh_); const bf16_t* st_ = STATES + ((size_t)((b * 32 + c) * 16 + h_) * 64) * 128; \
            _Pragma("unroll") for (int i_ = 0; i_ < 2; ++i_) { const int id_ = tid + 512 * i_; \
                px[i_] = *(const u32x4*)(XC + (tok0 + (id_ >> 3)) * 1024 + 64 * h_ + 8 * (id_ & 7)); ps[i_] = *(const u32x4*)(st_ + (size_t)(id_ >> 4) * 128 + (id_ & 15) * 8); \
                pz[i_] = *(const u32x4*)(Z + (tok0 + (id_ >> 3)) * 1024 + 64 * h_ + 8 * (id_ & 7)); } } while (0)
        PC_FETCH(0);
#pragma unroll
        for (int i = 0; i < 2; ++i) { const int id = tid + 512 * i, l = id >> 3, hh = id & 7; csr[i] = CSG[(tok0 + l) * 16 + 8 * g + hh]; dtr[i] = DTG[(tok0 + l) * 16 + 8 * g + hh]; }
        {   const int cc = tid & 15, pr = tid >> 4; float o[4][8];
            conv8<4>(xb, s_base + 4 * pr, 1280 + g * 128 + 8 * cc, conv_w, conv_b, o);
#pragma unroll
            for (int r = 0; r < 4; ++r) *(LAS u32x4*)(Cs + (4 * pr + r) * 272 + cc * 16) = pack8(o[r]);
            conv8<4>(xb, s_base + 4 * pr, 1024 + g * 128 + 8 * cc, conv_w, conv_b, o);
#pragma unroll
            for (int r = 0; r < 4; ++r) *(LAS u32x4*)(Bm + (4 * pr + r) * 272 + cc * 16) = pack8(o[r]);
        }
#pragma unroll
        for (int i = 0; i < 2; ++i) { const int id = tid + 512 * i, l = id >> 3, hh = id & 7; csl[hh * 128 + l] = csr[i]; dtl[hh * 128 + l] = dtr[i]; }
        __syncthreads();
        const int tr = w >> 1, tc0 = 2 * (w & 1);
        f32x16 cb[2]; cb[0] = zero16(); cb[1] = zero16();
#pragma unroll
        for (int ks = 0; ks < 8; ++ks) { const bf16x8 a = row_frag(Cs, 272, 32 * tr, 16 * ks, lane);
            cb[0] = MFMA32(row_frag(Bm, 272, 32 * tc0, 16 * ks, lane), a, cb[0]); cb[1] = MFMA32(row_frag(Bm, 272, 32 * tc0 + 32, 16 * ks, lane), a, cb[1]); }
        __syncthreads();
        float ssq1 = 0.f;
        const int tp = w & 1;
#pragma unroll 1
        for (int hh = 0; hh < 8; ++hh) {
            const int h = 8 * g + hh;
            {
#pragma unroll
                for (int i = 0; i < 2; ++i) { const int id = tid + 512 * i; *(LAS u32x4*)(Xs + (id >> 3) * 192 + (id & 7) * 16) = px[i]; *(LAS u32x4*)(PVs + (id >> 4) * 272 + (id & 15) * 16) = ps[i]; }
#pragma unroll
                for (int i = 0; i < 2; ++i) { const int id = tid + 512 * i, l = id >> 3, part = id & 7; LAS u32x4* zp = (LAS u32x4*)(Zs + l * 144 + part * 16);
                    if (hh > 0) *(u32x4*)(YSSD + (tok0 + l) * 1024 + 64 * (h - 1) + 8 * part) = *zp;
                    *zp = pz[i]; }
            }
#pragma unroll
            for (int j = 0; j < 2; ++j) { const int l = 32 * tr + r32; const float csl_l = csl[hh * 128 + l];
#pragma unroll
                for (int q = 0; q < 4; ++q) { const int s0 = 32 * (tc0 + j) + 8 * q + 4 * hi; const f32x4 cs4 = *(LAS const f32x4*)(csl + hh * 128 + s0), dt4 = *(LAS const f32x4*)(dtl + hh * 128 + s0); float v[4];
#pragma unroll
                    for (int i = 0; i < 4; ++i) v[i] = (s0 + i <= l) ? cb[j][4 * q + i] * __expf(csl_l - cs4[i]) * dt4[i] : 0.f;
                    u32x2 o; o.x = pkbf(v[0], v[1]); o.y = pkbf(v[2], v[3]); *(LAS u32x2*)(Bm + l * 272 + s0 * 2) = o; } }
            __syncthreads();
            { const int hn = hh < 7 ? hh + 1 : 7; PC_FETCH(hn); }
            f32x16 a1 = zero16(), a2 = zero16();
#pragma unroll
            for (int ks = 0; ks < 8; ++ks) a1 = MFMA32(tr_frag(Xs, 192, 16 * ks, 32 * tp, lane), row_frag(Bm, 272, 32 * tr, 16 * ks, lane), a1);
#pragma unroll
            for (int ks = 0; ks < 8; ++ks) a2 = MFMA32(row_frag(PVs, 272, 32 * tp, 16 * ks, lane), row_frag(Cs, 272, 32 * tr, 16 * ks, lane), a2);
            {   const float dsk = d_skip[h]; const int l = 32 * tr + r32; const float el = __expf(csl[hh * 128 + l]);
#pragma unroll
                for (int q = 0; q < 4; ++q) { const int p0 = 32 * tp + 8 * q + 4 * hi; const u32x2 xw = *(LAS const u32x2*)(Xs + l * 192 + p0 * 2); LAS u32x2* zq = (LAS u32x2*)(Zs + l * 144 + p0 * 2); const u32x2 zw = *zq;
                    const float xv[4] = {bflo(xw.x), bfhi(xw.x), bflo(xw.y), bfhi(xw.y)}, zv[4] = {bflo(zw.x), bfhi(zw.x), bflo(zw.y), bfhi(zw.y)}; float yg[4];
#pragma unroll
                    for (int i = 0; i < 4; ++i) { const float y = a1[4 * q + i] + el * a2[4 * q + i] + dsk * xv[i]; yg[i] = y * zv[i]; ssq1 += yg[i] * yg[i]; }
                    u32x2 o; o.x = pkbf(yg[0], yg[1]); o.y = pkbf(yg[2], yg[3]); *zq = o; } }
            __syncthreads();
        }
#pragma unroll
        for (int i = 0; i < 2; ++i) { const int id = tid + 512 * i, l = id >> 3, part = id & 7; *(u32x4*)(YSSD + (tok0 + l) * 1024 + 64 * (8 * g + 7) + 8 * part) = *(LAS const u32x4*)(Zs + l * 144 + part * 16); }
#undef PC_FETCH
        { const float sr = ssq1 + lane_xor(ssq1, 32, lane); if (hi == 0) ssql[tp * 128 + 32 * tr + r32] = sr; }
        __syncthreads();
        {
            u32x4 yv[8][2];
#pragma unroll
            for (int hh = 0; hh < 8; ++hh)
#pragma unroll
                for (int i = 0; i < 2; ++i) { const int id = tid + 512 * i, l = id >> 3, part = id & 7; yv[hh][i] = *(const u32x4*)(YSSD + (tok0 + l) * 1024 + 64 * (8 * g + hh) + 8 * part); }
#pragma unroll
            for (int i = 0; i < 2; ++i) { const int id = tid + 512 * i, l = id >> 3, part = id & 7; const float rs = 1.0f / sqrtf((ssql[l] + ssql[128 + l]) * (1.0f / 512.0f) + RMS_EPS);
#pragma unroll
                for (int hh = 0; hh < 8; ++hh) { float f[8]; unpack8(yv[hh][i], f);
#pragma unroll
                    for (int e = 0; e < 8; ++e) f[e] *= rs;
                    *(u32x4*)(YSSD + (tok0 + l) * 1024 + 64 * (8 * g + hh) + 8 * part) = pack8(f); } }
        }
        __syncthreads();
    }
}

constexpr int SG_W = 0, SG_V = 34816, SG_U = 75776, SG_P = 110592;
__device__ __forceinline__ void sgu_phase(const Ctx& F, bf16_t* U, const bf16_t* V, const float* VSTAT, const float* ln_g, const float* ln_b, const float* sgu_w, const float* sgu_b) {
    const int tid = F.tid(), lane = F.lane, w = F.wave, r32 = lane & 31, hi = lane >> 5;
    LAS unsigned char* Ws = F.lds + SG_W; LAS unsigned char* Vn = F.lds + SG_V; LAS unsigned char* Us = F.lds + SG_U; LAS float* prm = (LAS float*)(F.lds + SG_P);
    int gcur = -1;
    u32x4 rv[4], ru[4]; float rm[4], rr[4];
#define SG_FETCH(item_) do { const int g_ = (item_) >> 7; const size_t t0_ = (size_t)((item_) & 127) * 128; \
        _Pragma("unroll") for (int i_ = 0; i_ < 4; ++i_) { const int id_ = tid + 512 * i_; const size_t tk_ = t0_ + (id_ >> 4); \
            rv[i_] = *(const u32x4*)(V + tk_ * 1024 + 128 * g_ + 8 * (id_ & 15)); ru[i_] = *(const u32x4*)(U + tk_ * 1024 + 128 * g_ + 8 * (id_ & 15)); rm[i_] = VSTAT[2 * tk_]; rr[i_] = VSTAT[2 * tk_ + 1]; } } while (0)
#pragma unroll 1
    for (int k = 0; k < 4; ++k) {
        const int item = F.vcu * 4 + k; if (item >= 1024) break;
        const int g = item >> 7, bc = item & 127; const size_t tok0 = (size_t)bc * 128;
        if (g != gcur) { gcur = g;
            const int t = tid >> 2, part = tid & 3; const float* src = sgu_w + ((size_t)g * 128 + t) * 128 + 32 * part;
#pragma unroll
            for (int q = 0; q < 4; ++q) { const f32x4 a = *(const f32x4*)(src + 8 * q), bb = *(const f32x4*)(src + 8 * q + 4); float f[8] = {a.x, a.y, a.z, a.w, bb.x, bb.y, bb.z, bb.w};
#pragma unroll
                for (int e = 0; e < 8; ++e) if (32 * part + 8 * q + e > t) f[e] = 0.f;
                *(LAS u32x4*)(Ws + t * 272 + (32 * part + 8 * q) * 2) = pack8(f); }
            if (tid < 384) { const int j = tid & 127; prm[tid] = (tid < 128) ? ln_g[128 * g + j] : (tid < 256) ? ln_b[128 * g + j] : sgu_b[128 * g + j]; }
            __syncthreads();
        }
        if (k == 0) SG_FETCH(item);
#pragma unroll
        for (int i = 0; i < 4; ++i) { const int id = tid + 512 * i, s = id >> 4, part = id & 15;
            float f[8]; unpack8(rv[i], f); const float mean = rm[i], rstd = rr[i];
            const f32x4 g0 = *(LAS const f32x4*)(prm + 8 * part), g1 = *(LAS const f32x4*)(prm + 8 * part + 4), b0 = *(LAS const f32x4*)(prm + 128 + 8 * part), b1 = *(LAS const f32x4*)(prm + 128 + 8 * part + 4);
            const float gg[8] = {g0.x, g0.y, g0.z, g0.w, g1.x, g1.y, g1.z, g1.w}, bb[8] = {b0.x, b0.y, b0.z, b0.w, b1.x, b1.y, b1.z, b1.w};
#pragma unroll
            for (int e = 0; e < 8; ++e) f[e] = (f[e] - mean) * rstd * gg[e] + bb[e];
            *(LAS u32x4*)(Vn + s * 320 + part * 16) = pack8(f);
            *(LAS u32x4*)(Us + s * 272 + part * 16) = ru[i]; }
        __syncthreads();
        { const int nxt = (k < 3 && item + 1 < 1024) ? item + 1 : item; SG_FETCH(nxt); }
        const int tr = w >> 1, tc0 = 2 * (w & 1);
        f32x16 acc[2]; acc[0] = zero16(); acc[1] = zero16();
#pragma unroll
        for (int ks = 0; ks < 8; ++ks) { const bf16x8 a = row_frag(Ws, 272, 32 * tr, 16 * ks, lane);
            acc[0] = MFMA32(tr_frag(Vn, 320, 16 * ks, 32 * tc0, lane), a, acc[0]); acc[1] = MFMA32(tr_frag(Vn, 320, 16 * ks, 32 * tc0 + 32, lane), a, acc[1]); }
        {   const int t = 32 * tr + r32; const float bias = prm[256 + t];
#pragma unroll
            for (int j = 0; j < 2; ++j)
#pragma unroll
                for (int q = 0; q < 4; ++q) { LAS u32x2* up = (LAS u32x2*)(Us + t * 272 + (32 * (tc0 + j) + 8 * q + 4 * hi) * 2); const u32x2 uv = *up;
                    u32x2 o; o.x = pkbf(bflo(uv.x) * (acc[j][4 * q] + bias), bfhi(uv.x) * (acc[j][4 * q + 1] + bias)); o.y = pkbf(bflo(uv.y) * (acc[j][4 * q + 2] + bias), bfhi(uv.y) * (acc[j][4 * q + 3] + bias)); *up = o; } }
        __syncthreads();
#pragma unroll
        for (int i = 0; i < 4; ++i) { const int id = tid + 512 * i, s = id >> 4, part = id & 15;
            *(u32x4*)(U + (tok0 + s) * 1024 + 128 * g + 8 * part) = *(LAS const u32x4*)(Us + s * 272 + part * 16); }
    }
#undef SG_FETCH
}


constexpr int AT_K = 0, AT_KB = 13312, AT_V = 26624, AT_VB = 12288, AT_O = 63488;
__device__ __forceinline__ void attn_unit(const Ctx& F, int b, int h, int qb, const bf16_t* Q, const bf16_t* K, const bf16_t* V, bf16_t* O, const float* qhg, const float* ROPE,
                                          bool first, int qb_next, int& vcur, int& vprev, u32x4& ak0, u32x4& ak1, u32x4& av, u32x4 (&qn)[6]) {
    const int tid = F.tid(), lane = F.lane, w = F.wave, r32 = lane & 31, hi = lane >> 5;
    const size_t tok0 = (size_t)b * SEQ; const int q0 = qb * 256 + w * 32, NT = 4 * qb + 4;
    bf16x8 qf[6];
    {   float qv[6][8]; float ss = 0.f;
        if (first) {
#pragma unroll
            for (int ks = 0; ks < 6; ++ks) qn[ks] = *(const u32x4*)(Q + ((tok0 + q0 + r32) * 16 + h) * 96 + 16 * ks + 8 * hi); }
#pragma unroll
        for (int ks = 0; ks < 6; ++ks) { unpack8(qn[ks], qv[ks]);
#pragma unroll
            for (int e = 0; e < 8; ++e) ss += qv[ks][e] * qv[ks][e]; }
        ss += lane_xor(ss, 32, lane);
        const float rs = QSCALE / sqrtf(ss * (1.0f / 96.0f) + RMS_EPS);
#pragma unroll
        for (int ks = 0; ks < 6; ++ks) { const f32x4 g0 = *(const f32x4*)(qhg + 16 * ks + 8 * hi), g1 = *(const f32x4*)(qhg + 16 * ks + 8 * hi + 4);
            qv[ks][0] *= rs * g0.x; qv[ks][1] *= rs * g0.y; qv[ks][2] *= rs * g0.z; qv[ks][3] *= rs * g0.w; qv[ks][4] *= rs * g1.x; qv[ks][5] *= rs * g1.y; qv[ks][6] *= rs * g1.z; qv[ks][7] *= rs * g1.w; }
        const float* rp = ROPE + (size_t)(q0 + r32) * 32 + 16 * hi;
#pragma unroll
        for (int q4 = 0; q4 < 4; ++q4) { const f32x4 cs = *(const f32x4*)(rp + 4 * q4);
            { const float a = qv[4][2 * q4], bq = qv[5][2 * q4]; qv[4][2 * q4] = a * cs.x - bq * cs.y; qv[5][2 * q4] = a * cs.y + bq * cs.x; }
            { const float a = qv[4][2 * q4 + 1], bq = qv[5][2 * q4 + 1]; qv[4][2 * q4 + 1] = a * cs.z - bq * cs.w; qv[5][2 * q4 + 1] = a * cs.w + bq * cs.z; } }
#pragma unroll
        for (int ks = 0; ks < 6; ++ks) qf[ks] = __builtin_bit_cast(bf16x8, pack8(qv[ks]));
    }
    const int kk0 = tid / 12, kp0 = tid % 12, kk1 = (tid + 512) / 12, kp1 = (tid + 512) % 12, vk = tid >> 3, vp = tid & 7;
    const bf16_t* kg0 = K + ((tok0 + kk0) * 16 + h) * 96 + kp0 * 8; const bf16_t* kg1 = K + ((tok0 + kk1) * 16 + h) * 96 + kp1 * 8; const bf16_t* vg = V + ((tok0 + vk) * 16 + h) * 64 + vp * 8;
    const int kl0 = kk0 * 208 + kp0 * 16, kl1 = kk1 * 208 + kp1 * 16, vl = vk * 192 + vp * 16;
    const size_t tstepK = (size_t)64 * 16 * 96, tstepV = (size_t)64 * 16 * 64;
    u32x4 bk0, bk1 = (u32x4){0u, 0u, 0u, 0u}, bv;
    if (first) {
        vcur = 0; vprev = 2; ak1 = (u32x4){0u, 0u, 0u, 0u};
        ak0 = *(const u32x4*)kg0; if (tid < 256) ak1 = *(const u32x4*)kg1; av = *(const u32x4*)vg;
        *(LAS u32x4*)(F.lds + AT_K + kl0) = ak0; if (tid < 256) *(LAS u32x4*)(F.lds + AT_K + kl1) = ak1; *(LAS u32x4*)(F.lds + AT_V + vl) = av;
        ak0 = *(const u32x4*)(kg0 + tstepK); if (tid < 256) ak1 = *(const u32x4*)(kg1 + tstepK); av = *(const u32x4*)(vg + tstepV);
        __syncthreads();
    }
    float l_run = 0.f; f32x16 o0 = zero16(), o1 = zero16();
    const bool lag = w >= 4; bool pend = false;
    bf16x8 pb[4];
    bf16x8 kf[6], vf[4];
#define AT_KLOAD(Kb_, h_) do { _Pragma("unroll") for (int ks_ = 0; ks_ < 3; ++ks_) { kf[2 * ks_] = row_frag(Kb_, 208, 0, 16 * (3 * (h_) + ks_), lane); kf[2 * ks_ + 1] = row_frag(Kb_, 208, 32, 16 * (3 * (h_) + ks_), lane); } } while (0)
#define AT_VLOAD(Vb_, s_) do { vf[0] = tr_frag_acc(Vb_, 192, 16 * (s_), 0, lane); vf[1] = tr_frag_acc(Vb_, 192, 16 * (s_), 32, lane); vf[2] = tr_frag_acc(Vb_, 192, 32 + 16 * (s_), 0, lane); vf[3] = tr_frag_acc(Vb_, 192, 32 + 16 * (s_), 32, lane); } while (0)
#define AT_PVM(s_) do { __builtin_amdgcn_s_setprio(1); o0 = MFMA32(vf[0], pb[s_], o0); o1 = MFMA32(vf[1], pb[s_], o1); o0 = MFMA32(vf[2], pb[2 + (s_)], o0); o1 = MFMA32(vf[3], pb[2 + (s_)], o1); __builtin_amdgcn_s_setprio(0); } while (0)
#define AT_PVALL(Vb_) do { AT_VLOAD(Vb_, 0); __builtin_amdgcn_sched_barrier(0); AT_PVM(0); AT_VLOAD(Vb_, 1); __builtin_amdgcn_sched_barrier(0); AT_PVM(1); } while (0)
#define AT_STEP(t, LK0, LK1, LV, WK0, WK1, WV) do { \
        const int cur = (t) & 1, vnext = 3 - vcur - vprev; const bool act = 64 * (t) <= q0 + 31; \
        { const int tn_ = ((t) + 2 < NT) ? (t) + 2 : (t) + 2 - NT;        \
          LK0 = *(const u32x4*)(kg0 + (size_t)tn_ * tstepK); if (tid < 256) LK1 = *(const u32x4*)(kg1 + (size_t)tn_ * tstepK); LV = *(const u32x4*)(vg + (size_t)tn_ * tstepV); } \
        LAS const unsigned char* Kb = F.lds + AT_K + cur * AT_KB; LAS const unsigned char* Vb = F.lds + AT_V + vcur * AT_VB; \
        if (pend) { LAS const unsigned char* Vp = F.lds + AT_V + vprev * AT_VB; AT_PVALL(Vp); pend = false; } \
        if (act) { \
            AT_KLOAD(Kb, 0); __builtin_amdgcn_sched_barrier(0); \
            __builtin_amdgcn_s_setprio(1); \
            f32x16 p0 = MFMA32(kf[0], qf[0], zero16()), p1 = MFMA32(kf[1], qf[0], zero16()); \
            p0 = MFMA32(kf[2], qf[1], p0); p1 = MFMA32(kf[3], qf[1], p1); p0 = MFMA32(kf[4], qf[2], p0); p1 = MFMA32(kf[5], qf[2], p1); \
            __builtin_amdgcn_s_setprio(0); \
            AT_KLOAD(Kb, 1); __builtin_amdgcn_sched_barrier(0); \
            __builtin_amdgcn_s_setprio(1); \
            p0 = MFMA32(kf[0], qf[3], p0); p1 = MFMA32(kf[1], qf[3], p1); p0 = MFMA32(kf[2], qf[4], p0); p1 = MFMA32(kf[3], qf[4], p1); p0 = MFMA32(kf[4], qf[5], p0); p1 = MFMA32(kf[5], qf[5], p1); \
            __builtin_amdgcn_s_setprio(0); \
            if (64 * (t) + 63 > q0) { const int qa = q0 + r32; \
                _Pragma("unroll") for (int r = 0; r < 16; ++r) { const int ka = 64 * (t) + crow(r, hi); if (ka > qa) p0[r] = -INFINITY; if (ka + 32 > qa) p1[r] = -INFINITY; } } \
            float sum0 = 0.f, sum1 = 0.f;        \
            _Pragma("unroll") for (int r = 0; r < 16; ++r) { p0[r] = __builtin_amdgcn_exp2f(p0[r]); p1[r] = __builtin_amdgcn_exp2f(p1[r]); sum0 += p0[r]; asm("" : "+v"(sum0)); sum1 += p1[r]; asm("" : "+v"(sum1)); } \
            l_run += sum0 + sum1; \
            _Pragma("unroll") for (int s = 0; s < 2; ++s) { \
                { u32x4 x; x.x = pkbf(p0[8 * s + 0], p0[8 * s + 1]); x.y = pkbf(p0[8 * s + 2], p0[8 * s + 3]); x.z = pkbf(p0[8 * s + 4], p0[8 * s + 5]); x.w = pkbf(p0[8 * s + 6], p0[8 * s + 7]); pb[s] = __builtin_bit_cast(bf16x8, x); } \
                { u32x4 x; x.x = pkbf(p1[8 * s + 0], p1[8 * s + 1]); x.y = pkbf(p1[8 * s + 2], p1[8 * s + 3]); x.z = pkbf(p1[8 * s + 4], p1[8 * s + 5]); x.w = pkbf(p1[8 * s + 6], p1[8 * s + 7]); pb[2 + s] = __builtin_bit_cast(bf16x8, x); } } \
            if (lag) pend = true; else AT_PVALL(Vb); \
        } \
        { const int nx = cur ^ 1; *(LAS u32x4*)(F.lds + AT_K + nx * AT_KB + kl0) = WK0; if (tid < 256) *(LAS u32x4*)(F.lds + AT_K + nx * AT_KB + kl1) = WK1; *(LAS u32x4*)(F.lds + AT_V + vnext * AT_VB + vl) = WV; } \
        __syncthreads(); \
        vprev = vcur; vcur = vnext; } while (0)
#pragma unroll 1
    for (int t = 0; t < NT; t += 2) { AT_STEP(t, bk0, bk1, bv, ak0, ak1, av); AT_STEP(t + 1, ak0, ak1, av, bk0, bk1, bv); }
#undef AT_STEP
    { const int q0n = (qb_next >= 0 ? qb_next : qb) * 256 + w * 32;
#pragma unroll
      for (int ks = 0; ks < 6; ++ks) qn[ks] = *(const u32x4*)(Q + ((tok0 + q0n + r32) * 16 + h) * 96 + 16 * ks + 8 * hi); }
    if (pend) { LAS const unsigned char* Vp = F.lds + AT_V + vprev * AT_VB; AT_PVALL(Vp); }
#undef AT_KLOAD
#undef AT_VLOAD
#undef AT_PVM
#undef AT_PVALL
    l_run += lane_xor(l_run, 32, lane);
    const float inv = 1.0f / l_run;
    LAS bf16_t* stg = (LAS bf16_t*)(F.lds + AT_O + w * 4096);
#pragma unroll
    for (int r = 0; r < 16; ++r) { const int d = crow(r, hi); stg[r32 * 64 + d] = (bf16_t)(pkbf(o0[r] * inv, 0.f) & 0xffffu); stg[r32 * 64 + 32 + d] = (bf16_t)(pkbf(o1[r] * inv, 0.f) & 0xffffu); }
    LDS_WAIT(); asm volatile("" ::: "memory");
#pragma unroll
    for (int i = 0; i < 4; ++i) { const int row = i * 8 + (lane >> 3), ch = lane & 7; *(u32x4*)(O + ((tok0 + q0 + row) * 16 + h) * 64 + ch * 8) = *(LAS const u32x4*)(stg + row * 64 + ch * 8); }
    __syncthreads();
}
__device__ __forceinline__ void attn_phase(const Ctx& F, const bf16_t* Q, const bf16_t* K, const bf16_t* V, bf16_t* O, const float* qhg, const float* ROPE) {
    const int bh = F.vcu >> 2, s = F.vcu & 3;
    if (bh >= NBATCH * 16) return;
    int vcur = 0, vprev = 2; u32x4 ak0 = (u32x4){0u, 0u, 0u, 0u}, ak1 = ak0, av = ak0; u32x4 qn[6];
#pragma unroll
    for (int ks = 0; ks < 6; ++ks) qn[ks] = ak0;
#pragma unroll 1
    for (int i = 0; i < 4; ++i) { const int qb = (i == 0) ? s : (i == 1) ? 7 - s : (i == 2) ? 8 + s : 15 - s, qbn = (i == 0) ? 7 - s : (i == 1) ? 8 + s : (i == 2) ? 15 - s : -1;
        attn_unit(F, bh >> 4, bh & 15, qb, Q, K, V, O, qhg, ROPE, i == 0, qbn, vcur, vprev, ak0, ak1, av, qn); }
}

__device__ __forceinline__ void moe_offsets(const unsigned* CNT, int (&off)[9]) {
    off[0] = 0;
#pragma unroll
    for (int e = 0; e < 8; ++e) { const unsigned c = __hip_atomic_load(CNT + 64 * e, __ATOMIC_RELAXED, __HIP_MEMORY_SCOPE_AGENT); off[e + 1] = off[e] + __builtin_amdgcn_readfirstlane((int)((c + 255u) & ~255u)); }
}
constexpr int RT_LDS = 81920, RT_WAVES = 4, RT_MAXTOK = 16;
__device__ __forceinline__ void rt_barrier(LAS unsigned* bar, unsigned target, int lane) {
    LDS_WAIT(); asm volatile("" ::: "memory");
    if (lane == 0) __hip_atomic_fetch_add(bar, 1u, __ATOMIC_RELAXED, __HIP_MEMORY_SCOPE_WORKGROUP);
    for (;;) { const unsigned v = __builtin_amdgcn_readfirstlane(__hip_atomic_load(bar, __ATOMIC_RELAXED, __HIP_MEMORY_SCOPE_WORKGROUP)); if (v >= target) break; __builtin_amdgcn_s_sleep(1); }
    asm volatile("" ::: "memory");
}
__device__ __forceinline__ void moe_route(const Ctx& F, const bf16_t* x, const float* g, const float* Wr, unsigned* CNT, float* RSTD, int* TOKE, int* TOKP, float* TOKW, unsigned* ARR, int* TOKR, bf16_t* AG) {
    const int gw = F.vcu * RT_WAVES + F.wave, NGW = F.G * RT_WAVES, lane = F.lane;
    LAS unsigned* lcnt = (LAS unsigned*)(F.lds + RT_LDS); LAS unsigned* lbase = lcnt + 8; LAS unsigned* lbar = lcnt + 17; LAS unsigned* lrec = lcnt + 32 + F.wave * (2 * RT_MAXTOK);
    int nt = 0;
    f32x4 gv[4];
#pragma unroll
    for (int j = 0; j < 4; ++j) gv[j] = ((const f32x4*)g)[lane + 64 * j];
    f32x4 wreg[4][4][2];
#pragma unroll
    for (int j = 0; j < 4; ++j)
#pragma unroll
        for (int i = 0; i < 4; ++i) { const float* wr = Wr + (size_t)(4 * (lane + 64 * j) + i) * 8; wreg[j][i][0] = *(const f32x4*)wr; wreg[j][i][1] = *(const f32x4*)(wr + 4); }
    u32x2 vn[4], vn2[4];
    if (gw < NTOK) { const u32x2* xr = (const u32x2*)(x + (size_t)gw * DM) + lane; const int m2 = gw + NGW < NTOK ? gw + NGW : gw; const u32x2* xr2 = (const u32x2*)(x + (size_t)m2 * DM) + lane;
#pragma unroll
        for (int j = 0; j < 4; ++j) { vn[j] = xr[64 * j]; vn2[j] = xr2[64 * j]; } }
#pragma unroll 1
    for (int m = gw; m < NTOK; m += NGW) {
        f32x4 v[4]; float s = 0.f;
#pragma unroll
        for (int j = 0; j < 4; ++j) { const u32x2 q = vn[j]; v[j] = (f32x4){bflo(q.x), bfhi(q.x), bflo(q.y), bfhi(q.y)}; s += (v[j].x * v[j].x + v[j].y * v[j].y) + (v[j].z * v[j].z + v[j].w * v[j].w); vn[j] = vn2[j]; }
        { const int pf = (m + 2 * NGW < NTOK) ? m + 2 * NGW : m; const u32x2* xr = (const u32x2*)(x + (size_t)pf * DM) + lane;
#pragma unroll
          for (int j = 0; j < 4; ++j) vn2[j] = xr[64 * j]; }
        const float rstd = 1.0f / sqrtf(wave_sum(s, lane) * (1.0f / DM) + RMS_EPS);
        float lg[8];
#pragma unroll
        for (int e = 0; e < 8; ++e) lg[e] = 0.f;
#pragma unroll
        for (int j = 0; j < 4; ++j) { const float hv[4] = {v[j].x * rstd * gv[j].x, v[j].y * rstd * gv[j].y, v[j].z * rstd * gv[j].z, v[j].w * rstd * gv[j].w};
#pragma unroll
            for (int i = 0; i < 4; ++i) { const f32x4 a = wreg[j][i][0], bq = wreg[j][i][1];
                lg[0] += hv[i] * a.x; lg[1] += hv[i] * a.y; lg[2] += hv[i] * a.z; lg[3] += hv[i] * a.w; lg[4] += hv[i] * bq.x; lg[5] += hv[i] * bq.y; lg[6] += hv[i] * bq.z; lg[7] += hv[i] * bq.w; } }
        {
            const bool b0 = lane & 1, b1 = lane & 2, b2 = lane & 4; float k4[4], k2[2], k1;
#pragma unroll
            for (int i = 0; i < 4; ++i) { const float keep = b0 ? lg[4 + i] : lg[i], send = b0 ? lg[i] : lg[4 + i]; k4[i] = keep + lane_xor(send, 1, lane); }
#pragma unroll
            for (int i = 0; i < 2; ++i) { const float keep = b1 ? k4[2 + i] : k4[i], send = b1 ? k4[i] : k4[2 + i]; k2[i] = keep + lane_xor(send, 2, lane); }
            { const float keep = b2 ? k2[1] : k2[0], send = b2 ? k2[0] : k2[1]; k1 = keep + lane_xor(send, 4, lane); }
            k1 += lane_xor(k1, 8, lane); k1 += lane_xor(k1, 16, lane); k1 += lane_xor(k1, 32, lane);
#pragma unroll
            for (int e = 0; e < 8; ++e) lg[e] = __int_as_float(__builtin_amdgcn_readlane(__float_as_int(k1), (e >> 2) + 2 * ((e >> 1) & 1) + 4 * (e & 1)));
        }
        int i0 = 0; float v0 = lg[0];
#pragma unroll
        for (int e = 1; e < 8; ++e) if (lg[e] > v0) { v0 = lg[e]; i0 = e; }
        int i1 = -1; float v1 = -INFINITY;
#pragma unroll
        for (int e = 0; e < 8; ++e) if (e != i0 && lg[e] > v1) { v1 = lg[e]; i1 = e; }
        if (lane == 0) {
            const float w0 = 1.0f / (1.0f + __expf(v1 - v0));
            const unsigned p0 = __hip_atomic_fetch_add(lcnt + i0, 1u, __ATOMIC_RELAXED, __HIP_MEMORY_SCOPE_WORKGROUP), p1 = __hip_atomic_fetch_add(lcnt + i1, 1u, __ATOMIC_RELAXED, __HIP_MEMORY_SCOPE_WORKGROUP);
            RSTD[m] = rstd; TOKE[2 * m] = i0; TOKE[2 * m + 1] = i1; TOKW[2 * m] = w0; TOKW[2 * m + 1] = 1.0f - w0;
            if (nt < RT_MAXTOK) { lrec[2 * nt] = ((unsigned)i0 << 16) | p0; lrec[2 * nt + 1] = ((unsigned)i1 << 16) | p1; ((LAS float*)(lcnt + 160 + F.wave * RT_MAXTOK))[nt] = rstd; }
        }
        ++nt;
    }
    rt_barrier(lbar, RT_WAVES, lane);
    if (F.wave == 0 && lane < 8) lbase[lane] = atomicAdd(CNT + 64 * lane, lcnt[lane]);
    rt_barrier(lbar, 2 * RT_WAVES, lane);
    if (lane < 2 * nt && lane < 2 * RT_MAXTOK) { const unsigned rec = lrec[lane]; const int m = gw + (lane >> 1) * NGW; TOKP[2 * m + (lane & 1)] = (int)(lbase[rec >> 16] + (rec & 0xffffu)); }
    if (F.wave == 0 && lane == 0) __hip_atomic_fetch_add(ARR, 1u, __ATOMIC_RELAXED, __HIP_MEMORY_SCOPE_AGENT);
    for (;;) { const unsigned v = __builtin_amdgcn_readfirstlane(__hip_atomic_load(ARR, __ATOMIC_RELAXED, __HIP_MEMORY_SCOPE_AGENT)); if (v >= (unsigned)F.G) break; __builtin_amdgcn_s_sleep(8); }
    int off[9]; moe_offsets(CNT, off);
    if (nt > RT_MAXTOK) nt = RT_MAXTOK;
    const LAS float* lrs = (const LAS float*)(lcnt + 160 + F.wave * RT_MAXTOK);
#define RS_LOAD(X_, t_) do { const u32x2* xr_ = (const u32x2*)(x + (size_t)(gw + (t_) * NGW) * DM) + lane; _Pragma("unroll") for (int j_ = 0; j_ < 4; ++j_) X_[j_] = xr_[64 * j_]; } while (0)
#define RS_DO(X_, t_) do { const int m_ = gw + (t_) * NGW; const unsigned ra_ = (unsigned)__builtin_amdgcn_readfirstlane((int)lrec[2 * (t_)]), rb_ = (unsigned)__builtin_amdgcn_readfirstlane((int)lrec[2 * (t_) + 1]); \
        const int e0_ = (int)(ra_ >> 16), e1_ = (int)(rb_ >> 16); int r0 = (int)(lbase[e0_] + (ra_ & 0xffffu)), r1 = (int)(lbase[e1_] + (rb_ & 0xffffu)); \
        _Pragma("unroll") for (int e_ = 0; e_ < 8; ++e_) { if (e_ == e0_) r0 += off[e_]; if (e_ == e1_) r1 += off[e_]; } \
        const float rstd_ = lrs[t_]; if (lane == 0) { TOKR[2 * m_] = r0; TOKR[2 * m_ + 1] = r1; } \
        u32x2* o0 = (u32x2*)(AG + (size_t)r0 * DM) + lane; u32x2* o1 = (u32x2*)(AG + (size_t)r1 * DM) + lane; \
        _Pragma("unroll") for (int j = 0; j < 4; ++j) { const u32x2 q = X_[j]; u32x2 wv; wv.x = pkbf(bflo(q.x) * rstd_ * gv[j].x, bfhi(q.x) * rstd_ * gv[j].y); wv.y = pkbf(bflo(q.y) * rstd_ * gv[j].z, bfhi(q.y) * rstd_ * gv[j].w); o0[64 * j] = wv; o1[64 * j] = wv; } } while (0)
    if (nt > 0) { u32x2 xa[4], xb[4]; RS_LOAD(xa, 0);
#pragma unroll 1
        for (int t = 0; t < nt; t += 2) {
            { const int tn = t + 1 < nt ? t + 1 : t; RS_LOAD(xb, tn); }
            RS_DO(xa, t);
            if (t + 1 >= nt) break;
            { const int tn = t + 2 < nt ? t + 2 : t + 1; RS_LOAD(xa, tn); }
            RS_DO(xb, t + 1);
        } }
#undef RS_LOAD
#undef RS_DO
}
__device__ __forceinline__ void moe_scatter(const Ctx& F, const bf16_t* x, const float* g, const unsigned* CNT, const float* RSTD, const int* TOKE, const int* TOKP, int* TOKR, bf16_t* AG) {
    const int gw = F.vcu * NWAVES + F.wave, NGW = F.G * NWAVES, lane = F.lane;
    int off[9]; moe_offsets(CNT, off);
    f32x4 gv[4];
#pragma unroll
    for (int j = 0; j < 4; ++j) gv[j] = ((const f32x4*)g)[lane + 64 * j];
    struct Tok { f32x4 v[4]; float rstd; int e0, e1, p0, p1; };
#define SC_LOAD(T_, m_) do { const u32x2* xr_ = (const u32x2*)(x + (size_t)(m_) * DM) + lane; _Pragma("unroll") for (int j_ = 0; j_ < 4; ++j_) { const u32x2 q_ = xr_[64 * j_]; T_.v[j_] = (f32x4){bflo(q_.x), bfhi(q_.x), bflo(q_.y), bfhi(q_.y)}; } \
        T_.rstd = RSTD[m_]; T_.e0 = TOKE[2 * (m_)]; T_.e1 = TOKE[2 * (m_) + 1]; T_.p0 = TOKP[2 * (m_)]; T_.p1 = TOKP[2 * (m_) + 1]; } while (0)
#define SC_DO(T_, m_) do { int r0 = T_.p0, r1 = T_.p1; _Pragma("unroll") for (int e_ = 0; e_ < 8; ++e_) { if (e_ == T_.e0) r0 += off[e_]; if (e_ == T_.e1) r1 += off[e_]; } \
        if (lane == 0) { TOKR[2 * (m_)] = r0; TOKR[2 * (m_) + 1] = r1; } \
        u32x2* o0 = (u32x2*)(AG + (size_t)r0 * DM) + lane; u32x2* o1 = (u32x2*)(AG + (size_t)r1 * DM) + lane; const float rstd = T_.rstd; \
        _Pragma("unroll") for (int j = 0; j < 4; ++j) { const f32x4 v = T_.v[j]; u32x2 wv; wv.x = pkbf(v.x * rstd * gv[j].x, v.y * rstd * gv[j].y); wv.y = pkbf(v.z * rstd * gv[j].z, v.w * rstd * gv[j].w); o0[64 * j] = wv; o1[64 * j] = wv; } } while (0)
    int m = gw; if (m >= NTOK) return;
    Tok ta, tb;
    SC_LOAD(ta, m);
#pragma unroll 1
    for (;;) {
        const int n1 = m + NGW; { const int pf = n1 < NTOK ? n1 : m; SC_LOAD(tb, pf); }
        SC_DO(ta, m);
        if (n1 >= NTOK) break;
        const int n2 = n1 + NGW; { const int pf = n2 < NTOK ? n2 : n1; SC_LOAD(ta, pf); }
        SC_DO(tb, n1);
        if (n2 >= NTOK) break;
        m = n2;
    }
#undef SC_LOAD
#undef SC_DO
}
__device__ __forceinline__ void moe_combine(const Ctx& F, const bf16_t* x, float* out, const bf16_t* YP, const bf16_t* YPT, const int* TOKR, const float* TOKW) {
    const int gw = F.vcu * NWAVES + F.wave, NGW = F.G * NWAVES, lane = F.lane;
    struct Idx { float w0, w1; int r0, r1; };
    struct Tok { f32x4 v[4]; u32x2 y0[4], y1[4]; };
#define CB_LDI(I_, m_) do { I_.r0 = TOKR[2 * (m_)]; I_.r1 = TOKR[2 * (m_) + 1]; I_.w0 = TOKW[2 * (m_)]; I_.w1 = TOKW[2 * (m_) + 1]; } while (0)
#define CB_LDR(T_, I_, m_) do { const u32x2* xr_ = (const u32x2*)(x + (size_t)(m_) * DM) + lane; _Pragma("unroll") for (int j_ = 0; j_ < 4; ++j_) { const u32x2 q_ = xr_[64 * j_]; T_.v[j_] = (f32x4){bflo(q_.x), bfhi(q_.x), bflo(q_.y), bfhi(q_.y)}; } \
        const int a_ = I_.r0 < 128 * 256 ? I_.r0 : 0, b_ = I_.r1 < 128 * 256 ? I_.r1 : 0; const u32x2* ya_ = (const u32x2*)(YP + (size_t)a_ * DM) + lane; const u32x2* yb_ = (const u32x2*)(YP + (size_t)b_ * DM) + lane; \
        _Pragma("unroll") for (int j_ = 0; j_ < 4; ++j_) { T_.y0[j_] = ya_[64 * j_]; T_.y1[j_] = yb_[64 * j_]; } } while (0)
#define CB_DO(T_, I_, m_) do { f32x4* xr = (f32x4*)(out + (size_t)(m_) * DM) + lane;       \
        _Pragma("unroll") for (int q = 0; q < 2; ++q) { const int r = q ? I_.r1 : I_.r0; const float wq = q ? I_.w1 : I_.w0; \
            if (r < 128 * 256) { _Pragma("unroll") for (int j = 0; j < 4; ++j) { const u32x2 a = q ? T_.y1[j] : T_.y0[j]; T_.v[j].x += wq * bflo(a.x); T_.v[j].y += wq * bfhi(a.x); T_.v[j].z += wq * bflo(a.y); T_.v[j].w += wq * bfhi(a.y); } } \
            else { u32x2 yt_[pg8::TAIL_PIECES][4];            \
                _Pragma("unroll") for (int pc = 0; pc < pg8::TAIL_PIECES; ++pc) { const u32x2* y = (const u32x2*)(YPT + ((size_t)pc * pg8::TAIL_ROWS + (r - 128 * 256)) * DM) + lane; _Pragma("unroll") for (int j = 0; j < 4; ++j) yt_[pc][j] = y[64 * j]; } \
                _Pragma("unroll") for (int pc = 0; pc < pg8::TAIL_PIECES; ++pc) { \
                    _Pragma("unroll") for (int j = 0; j < 4; ++j) { const u32x2 a = yt_[pc][j]; T_.v[j].x += wq * bflo(a.x); T_.v[j].y += wq * bfhi(a.x); T_.v[j].z += wq * bflo(a.y); T_.v[j].w += wq * bfhi(a.y); } } } } \
        _Pragma("unroll") for (int j = 0; j < 4; ++j) xr[64 * j] = T_.v[j]; } while (0)
    int m = gw; if (m >= NTOK) return;
    Tok ta, tb; Idx ia, ib, ic;
    CB_LDI(ia, m); { const int mb = m + NGW < NTOK ? m + NGW : m; CB_LDI(ib, mb); }
    CB_LDR(ta, ia, m);
#pragma unroll 1
    for (;;) {
        const int n1 = m + NGW, n2 = n1 + NGW, n3 = n2 + NGW;
        { const int p2 = n2 < NTOK ? n2 : (n1 < NTOK ? n1 : m); CB_LDI(ic, p2); }
        { const int p1 = n1 < NTOK ? n1 : m; CB_LDR(tb, ib, p1); }
        CB_DO(ta, ia, m);
        if (n1 >= NTOK) break;
        { const int p3 = n3 < NTOK ? n3 : (n2 < NTOK ? n2 : n1); CB_LDI(ia, p3); }
        { const int p2 = n2 < NTOK ? n2 : n1; CB_LDR(ta, ic, p2); }
        CB_DO(tb, ib, n1);
        if (n2 >= NTOK) break;
        { const Idx t = ic; ic = ib; ib = ia; ia = t; }
        m = n2;
    }
#undef CB_LDI
#undef CB_LDR
#undef CB_DO
}

#ifndef MK_N_LAUNCHES
#define MK_N_LAUNCHES 1
#endif
constexpr int PH_L0 = 9, PH_L1 = 11, N_PHASES = 1 + PH_L0 + PH_L1;
struct Args { const float* in[31]; float* out; unsigned char* ws; int ph_lo, ph_hi, use_bar, pad; };


typedef const __attribute__((address_space(4))) Args* cargs_t;
__device__ __forceinline__ cargs_t kargs() { cargs_t p = (cargs_t)__builtin_amdgcn_kernarg_segment_ptr(); asm volatile("" : "+s"(p)); return p; }
#define AIN(i) ((const float*)(const GAS float*)kargs()->in[i])
#define AWS ((GAS unsigned char*)kargs()->ws)
__device__ __forceinline__ GAS unsigned char* opq(GAS unsigned char* p) { asm volatile("" : "+s"(p)); return p; }
#ifndef MOE_GU_WGM
#define MOE_GU_WGM 2
#endif
#ifndef DUP17
#define DUP17 1
#endif
#ifndef EN_MASK
#define EN_MASK 0xFFFFFFFFu
#endif
#define EN(b) (((EN_MASK) >> (b)) & 1u)
#define WSV(type, off) ((type*)(GAS type*)(opq(AWS) + (off)))
__global__ void __launch_bounds__(NTHREADS, 2) mk_fwd(Args args) {
    extern __shared__ __attribute__((aligned(16))) unsigned char lds_raw[];
    const int wave_id0 = __builtin_amdgcn_readfirstlane((int)threadIdx.x >> 6);
    volatile LAS unsigned* MISCW = (volatile LAS unsigned*)((LAS unsigned char*)lds_raw + LDS_MISC_OFF);
    if (threadIdx.x < 32) MISCW[threadIdx.x] = 0u;
    __syncthreads();
    if (kargs()->use_bar) (void)xcd_barrier_post((unsigned*)(GAS unsigned*)(AWS + WS_CTL) + CW_BAR, MISCW + 8);
#if defined(PROBE_MASK)
    unsigned long long probe_t0 = __builtin_amdgcn_s_memrealtime(), probe_acc = 0ull;
#endif
#pragma unroll 1
    for (int ph = kargs()->ph_lo; ph < kargs()->ph_hi; ++ph) {
        Ctx F; { unsigned ones_ = ~0u; asm volatile("" : "+s"(ones_));
                 int ln_ = __builtin_amdgcn_mbcnt_hi(ones_, __builtin_amdgcn_mbcnt_lo(ones_, 0u)), wv_ = wave_id0, bx = blockIdx.x, gd = gridDim.x; asm volatile("" : "+v"(ln_)); asm volatile("" : "+s"(bx), "+s"(gd), "+s"(wv_));
                 F.lds = (LAS unsigned char*)lds_raw; F.lane = ln_; F.wave = wv_; F.G = gd; F.vcu = (gd % 8 == 0) ? (bx % 8) * (gd / 8) + bx / 8 : bx; F.bx = bx; }
        const int L = (ph > PH_L0) ? 1 : 0, k = (ph == 0) ? -1 : (ph - 1 - L * PH_L0);
        float* X = (float*)(GAS float*)kargs()->out;
        const size_t wlo = WS_WL0 + (size_t)L * WS_WL_STRIDE;
        const float* ssq_in = (L == 0) ? nullptr : WSV(float, WS_SSQ + (size_t)NTOK * 64);
        if (EN(0) && k == -1) {
            if (F.tid() == 0) {
                LAS ConvJob* tab = (LAS ConvJob*)(F.lds + CJ_OFF); int nj = 0, tot = 0;
#define CJ_ADD(S_, D_, G_, K_, N_, KIND_) do { int k_ = (K_), n_ = (N_), kd_ = (KIND_); asm volatile("" : "+v"(k_), "+v"(n_), "+v"(kd_));     \
                    tab[nj].src = (S_); tab[nj].dst = (D_); tab[nj].gain = (G_); tab[nj].K = k_; tab[nj].N = n_; tab[nj].kind = kd_; tab[nj].start = tot; tot += (k_ / 64) * ((n_ + 63) / 64); ++nj; } while (0)
#pragma unroll 1
                for (int l2 = 0; l2 < 2; ++l2) {
                    GAS unsigned char* wl = opq(AWS) + WS_WL0 + (size_t)l2 * WS_WL_STRIDE;
                    if (l2 == 0) CJ_ADD(AIN(2), (bf16_t*)(GAS bf16_t*)(wl + WO_WIN), nullptr, DM, NIN, 1);
                    CJ_ADD(AIN(14) + (size_t)l2 * 256 * 1536, (bf16_t*)(GAS bf16_t*)(wl + WO_WUQ), nullptr, 256, 1536, 0);
                    CJ_ADD(AIN(16) + (size_t)l2 * 128 * 2048, (bf16_t*)(GAS bf16_t*)(wl + WO_WUKV), nullptr, 128, 2048, 0);
                    CJ_ADD(AIN(19) + (size_t)l2 * DM * DM, (bf16_t*)(GAS bf16_t*)(wl + WO_WBR), AIN(8) + l2 * 1024, DM, DM, 0);
                    CJ_ADD(AIN(20) + (size_t)l2 * DM * DM, (bf16_t*)(GAS bf16_t*)(wl + WO_WBR + 2 * MiB), nullptr, DM, DM, 0);
                    CJ_ADD(AIN(21) + (size_t)l2 * DM * DM, (bf16_t*)(GAS bf16_t*)(wl + WO_WBR + 4 * MiB), nullptr, DM, DM, 0);
                    CJ_ADD(AIN(22) + (size_t)l2 * DM * DM, (bf16_t*)(GAS bf16_t*)(wl + WO_WOUT), nullptr, DM, DM, 0);
                }
                CJ_ADD(AIN(24), WSV(bf16_t, WS_WGU), AIN(23), DM, FFD, 2);
                CJ_ADD(AIN(25), WSV(bf16_t, WS_WGU), AIN(23), DM, FFD, 3);
                CJ_ADD(AIN(26), WSV(bf16_t, WS_WDN), nullptr, FFD, DM, 0);
                tab[nj].start = tot;
#undef CJ_ADD
            }
            __syncthreads();
            convert_jobs(F, 16);
#pragma unroll 1
            for (int l2 = 0; l2 < 2; ++l2) { GAS unsigned char* wl = opq(AWS) + WS_WL0 + (size_t)l2 * WS_WL_STRIDE;
                for (int i = F.vcu * NTHREADS + F.tid(); i < 80 * DM / 8; i += F.G * NTHREADS) ((GAS u32x4*)(wl + WO_WIN + (size_t)2736 * DM * 2))[i] = (u32x4){0u, 0u, 0u, 0u}; }
            float* ROPE = WSV(float, WS_ROPE);
            for (int i = F.vcu * NTHREADS + F.tid(); i < SEQ * 16; i += F.G * NTHREADS) { const int pos = i >> 4, kk = i & 15;
                const float inv = __builtin_amdgcn_exp2f(-(float)kk * (13.287712379549449f / 16.0f)), ang = (float)pos * inv; float rev = ang * 0.15915494309189535f; rev -= floorf(rev); ROPE[2 * i] = __builtin_amdgcn_cosf(rev); ROPE[2 * i + 1] = __builtin_amdgcn_sinf(rev); }
            __syncthreads();
            { const int nit = __builtin_amdgcn_readfirstlane(((const LAS ConvJob*)(F.lds + CJ_OFF))[16].start), ngw = F.G * NWAVES;
              rmsnorm_rows(F, AIN(0), AIN(1), WSV(bf16_t, WS_H), nit - (nit / ngw) * ngw); }
        }
        else if (EN(2) && k == 0) {
            pg8::Gemm g{WSV(bf16_t, WS_H), WSV(bf16_t, wlo + WO_WIN), NTOK, 20 * 256, DM, DM}; pg8::StaticOrder S; S.init(NTOK, 20 * 256, F.G, F.bx);
            pg8::EpiIn E{WSV(bf16_t, WS_Z), WSV(bf16_t, WS_XBC), WSV(bf16_t, WS_QLAT), WSV(bf16_t, WS_U), WSV(bf16_t, WS_V), WSV(bf16_t, WS_GATES), WSV(float, WS_MISC), 0, ssq_in};
            pg8::gemm_phase<pg8::EpiIn, pg8::StaticOrder, true, true>(F.lds, g, S, E);
        }
        else if (EN(3) && k == 1) {
#ifdef DUP_R
            for (int rep_ = 0; rep_ < DUP_R; ++rep_)
#endif
            mixer_rowpass(F, WSV(bf16_t, WS_QLAT), WSV(float, WS_MISC), WSV(bf16_t, WS_V), AIN(13) + L * 256, AIN(15) + L * 128, WSV(bf16_t, WS_AQ), WSV(bf16_t, WS_AKV), WSV(float, WS_VSTAT));
#ifdef DUP_A
            for (int rep_ = 0; rep_ < DUP_A; ++rep_)
#endif
            ssd_pass_a(F, WSV(bf16_t, WS_XBC), WSV(float, WS_MISC), AIN(3) + L * 4 * 1536, AIN(4) + L * 1536, AIN(5) + L * 16, AIN(6) + L * 16,
                       WSV(bf16_t, WS_STATES), WSV(float, WS_CSG), WSV(float, WS_DTG), WSV(float, WS_CDEC), (bf16_t*)X);
        }
        else if (EN(4) && k == 2) {
#pragma unroll 1
            for (int i = 0; i < 2; ++i) {
                const int n = i ? 2048 : 1536, kd = i ? 128 : 256;
                pg8::Gemm g{WSV(bf16_t, i ? WS_AKV : WS_AQ), WSV(bf16_t, wlo + (i ? WO_WUKV : WO_WUQ)), NTOK, n, kd, kd}; pg8::StaticOrder S; S.init(NTOK, n, F.G, F.bx);
                pg8::EpiQKV E{WSV(bf16_t, i ? WS_KVRAW : WS_QRAW), n, WSV(bf16_t, WS_VM), i};
                pg8::gemm_phase<pg8::EpiQKV, pg8::StaticOrder, true, true>(F.lds, g, S, E);
            }
            ssd_scan(F, WSV(bf16_t, WS_STATES), WSV(float, WS_CDEC));
            sgu_phase(F, WSV(bf16_t, WS_U), WSV(bf16_t, WS_V), WSV(float, WS_VSTAT), AIN(9) + L * 1024, AIN(10) + L * 1024, AIN(11) + (size_t)L * 8 * 128 * 128, AIN(12) + L * 8 * 128);
        }
        else if (EN(5) && k == 3) {
            qk_finalize(F, WSV(bf16_t, WS_KVRAW), WSV(float, WS_MISC), AIN(18) + L * 96, WSV(float, WS_ROPE), WSV(bf16_t, WS_K));
#ifdef DUP_C
            for (int rep_ = 0; rep_ < DUP_C; ++rep_)
#endif
            ssd_pass_c(F, WSV(bf16_t, WS_XBC), WSV(bf16_t, WS_STATES), WSV(float, WS_CSG), WSV(float, WS_DTG), WSV(bf16_t, WS_Z), AIN(3) + L * 4 * 1536, AIN(4) + L * 1536,
                       AIN(7) + L * 16, (const bf16_t*)X, WSV(bf16_t, WS_YSSD));
        }
        else if (EN(6) && k == 4) {
            attn_phase(F, WSV(bf16_t, WS_QRAW), WSV(bf16_t, WS_K), WSV(bf16_t, WS_VM), WSV(bf16_t, WS_O), AIN(17) + L * 96, WSV(float, WS_ROPE));
        }
        else if (EN(7) && k == 5) {
            pg8::Gemm g{WSV(bf16_t, WS_H), WSV(bf16_t, wlo + WO_WIN) + (size_t)20 * 256 * DM, NTOK, 24 * 256, DM, DM};
            pg8::MixOrder S; S.so.init(NTOK, DM, F.G, F.bx); S.aoff[0] = WS_YSSD - WS_H; S.aoff[1] = WS_U - WS_H; S.aoff[2] = WS_O - WS_H;
            S.boff = (WO_WBR - (WO_WIN + (size_t)20 * 256 * DM * 2)) - (size_t)12 * 256 * DM * 2;
            pg8::EpiMix E{WSV(bf16_t, WS_MERGED), WSV(bf16_t, WS_GATES), ssq_in};
            pg8::gemm_phase<pg8::EpiMix, pg8::MixOrder, true, true>(F.lds, g, S, E);
        }
        else if (EN(8) && k == 6) {
            pg8::Gemm g{WSV(bf16_t, WS_MERGED), WSV(bf16_t, wlo + WO_WOUT), NTOK, DM, DM, DM}; pg8::StaticOrder S; S.init(NTOK, DM, F.G, F.bx);
            pg8::EpiResid E{(L == 0) ? AIN(0) : nullptr, WSV(bf16_t, WS_H), (L == 0) ? WSV(bf16_t, WS_H) : WSV(bf16_t, WS_XB2), (L == 0) ? WSV(float, WS_SSQ) : nullptr};
            pg8::gemm_phase<pg8::EpiResid, pg8::StaticOrder, true, true>(F.lds, g, S, E);
        }
        else if (EN(9) && L == 0 && k == 7) {
            pg8::Gemm g{WSV(bf16_t, WS_H), WSV(bf16_t, WS_WGU), NTOK, 2 * FFD, DM, DM}; pg8::StaticOrder S; S.init(NTOK, 2 * FFD, F.G, F.bx); pg8::EpiSwiglu E{WSV(bf16_t, WS_HID), FFD, WSV(float, WS_SSQ)};
            pg8::gemm_phase<pg8::EpiSwiglu, pg8::StaticOrder, true, true>(F.lds, g, S, E);
            const bool halfg = (F.G == 256);
            if (!halfg || F.bx >= 128) {
                __syncthreads();
                if (F.tid() == 0) { LAS ConvJob* tab = (LAS ConvJob*)(F.lds + CJ_OFF); int k_ = DM, n_ = NIN, kd_ = 1; asm volatile("" : "+v"(k_), "+v"(n_), "+v"(kd_));
                    tab[0].src = AIN(2) + (size_t)DM * NIN; tab[0].dst = (bf16_t*)(GAS bf16_t*)(opq(AWS) + WS_WL0 + WS_WL_STRIDE + WO_WIN); tab[0].gain = AIN(1) + DM; tab[0].K = k_; tab[0].N = n_; tab[0].kind = kd_; tab[0].start = 0;
                    tab[1].start = (k_ / 64) * ((n_ + 63) / 64); }
                __syncthreads();
                Ctx F2 = F; if (halfg) { F2.vcu = F.bx - 128; F2.G = 128; }
                convert_jobs(F2, 1);
            }
        }
        else if (EN(9) && L == 0 && k == 8) {
            pg8::Gemm g{WSV(bf16_t, WS_HID), WSV(bf16_t, WS_WDN), NTOK, DM, FFD, FFD}; pg8::StaticOrder S; S.init(NTOK, DM, F.G, F.bx);
            pg8::EpiResid E{nullptr, WSV(bf16_t, WS_H), WSV(bf16_t, WS_H), WSV(float, WS_SSQ + (size_t)NTOK * 64)};
            pg8::gemm_phase<pg8::EpiResid, pg8::StaticOrder, true, true>(F.lds, g, S, E);
        }
        else if (EN(10) && L == 1 && k == 7) {
            {   LAS unsigned* rl = (LAS unsigned*)(F.lds + RT_LDS); const int tid = F.tid(); if (tid < 32) rl[tid] = 0u;
                __syncthreads();
                if (F.wave < RT_WAVES) moe_route(F, WSV(bf16_t, WS_XB2), AIN(23) + DM, AIN(27), WSV(unsigned, WS_CTL) + CW_CNT, WSV(float, WS_RSTD), WSV(int, WS_TOKE), WSV(int, WS_TOKP), WSV(float, WS_TOKW),
                                                    WSV(unsigned, WS_CTL) + CW_CNT + 64 * 8, WSV(int, WS_TOKR), WSV(bf16_t, WS_AG));
                convert_moe(F, AIN(28), AIN(29), AIN(30), WSV(bf16_t, WS_WMGU), WSV(bf16_t, WS_WMDN), rl + 16); }
#if DUP17 > 1
#pragma unroll 1
            for (int e = 0; e < NEXP; ++e) {
                convert_probe<DUP17 - 1>(F, AIN(28) + (size_t)e * DM * FFE, DM, FFE, WSV(bf16_t, WS_AG) + (size_t)e * 3 * FFE * DM);
                convert_probe<DUP17 - 1>(F, AIN(29) + (size_t)e * DM * FFE, DM, FFE, WSV(bf16_t, WS_AG) + (size_t)e * 3 * FFE * DM + (size_t)FFE * DM);
                convert_probe<DUP17 - 1>(F, AIN(30) + (size_t)e * FFE * DM, FFE, DM, WSV(bf16_t, WS_AG) + (size_t)e * 3 * FFE * DM + (size_t)2 * FFE * DM);
            }
#endif
            __syncthreads();
        }
        else if (EN(10) && L == 1 && k == 8) {
            int off[9]; moe_offsets(WSV(unsigned, WS_CTL) + CW_CNT, off);
            pg8::Gemm g{WSV(bf16_t, WS_AG), WSV(bf16_t, WS_WMGU), off[8], 2 * FFE, DM, DM}; pg8::MoeOrder S; S.so.init(off[8], 2 * FFE, F.G, F.bx, MOE_GU_WGM); S.estride = (size_t)2 * FFE * DM * 2;
#pragma unroll
            for (int e = 0; e < 9; ++e) S.toff[e] = off[e] >> 8;
            pg8::EpiSwiglu E{WSV(bf16_t, WS_HIDM), FFE, nullptr};
            pg8::gemm_phase<pg8::EpiSwiglu, pg8::MoeOrder, true, true>(F.lds, g, S, E);
        }
        else if (EN(10) && L == 1 && k == 9) {
            int off[9]; moe_offsets(WSV(unsigned, WS_CTL) + CW_CNT, off);
            { pg8::Gemm g{WSV(bf16_t, WS_HIDM), WSV(bf16_t, WS_WMDN), 128 * 256, DM, FFE, FFE}; pg8::MoeOrder S; S.so.init(128 * 256, DM, F.G, F.bx); S.estride = (size_t)DM * FFE * 2;
#pragma unroll
              for (int e = 0; e < 9; ++e) S.toff[e] = off[e] >> 8;
              pg8::EpiPlain E{WSV(bf16_t, WS_YP), DM};
              pg8::gemm_phase<pg8::EpiPlain, pg8::MoeOrder, true, true>(F.lds, g, S, E); }
            { pg8::Gemm g{WSV(bf16_t, WS_HIDM), WSV(bf16_t, WS_WMDN), off[8], DM, 512, FFE}; pg8::TailOrder S; S.ntail = ((off[8] >> 8) - 128) * 4; S.c = F.vcu; S.estride = (size_t)DM * FFE * 2;
#pragma unroll
              for (int e = 0; e < 9; ++e) S.toff[e] = off[e] >> 8;
              pg8::EpiTail E{WSV(bf16_t, WS_YPT)};
              pg8::gemm_phase<pg8::EpiTail, pg8::TailOrder, true, true>(F.lds, g, S, E); }
        }
        else if (EN(10) && L == 1 && k == 10) {
            moe_combine(F, WSV(bf16_t, WS_XB2), X, WSV(bf16_t, WS_YP), WSV(bf16_t, WS_YPT), WSV(int, WS_TOKR), WSV(float, WS_TOKW));
        }
#if defined(PROBE_MASK)
        const unsigned long long pt0_ = probe_t0;
#endif
        if (ph + 1 < kargs()->ph_hi) { XcdBarrier b2; b2.bar = (unsigned*)(GAS unsigned*)(opq(AWS) + WS_CTL) + CW_BAR; b2.x = xb_xcc_id(); b2.st = MISCW + 8; xcd_barrier(b2); }
#if defined(PROBE_MASK)
        { const unsigned long long now = __builtin_amdgcn_s_memrealtime(); if ((PROBE_MASK >> ph) & 1ull) probe_acc += now - pt0_; probe_t0 = now; }
#endif
    }
#if defined(DUP_BAR)
    for (int xb_ = 0; xb_ < DUP_BAR; ++xb_) { XcdBarrier b2; b2.bar = (unsigned*)(GAS unsigned*)(opq(AWS) + WS_CTL) + CW_BAR; b2.x = xb_xcc_id(); b2.st = MISCW + 8; xcd_barrier(b2); }
#endif
#if defined(PROBE_MASK)
    { const unsigned long long until = __builtin_amdgcn_s_memrealtime() + (unsigned long long)(PROBE_MULT) * probe_acc; while (__builtin_amdgcn_s_memrealtime() < until) __builtin_amdgcn_s_sleep(8); }
#endif
}

extern "C" void kernel_launch(void* const* d_in, const int* in_sizes, int n_in, void* d_out, int out_size, void* d_ws, size_t ws_size, hipStream_t stream) {
    static int grid = 0;
    if (grid == 0) {
        if (n_in != 31 || in_sizes[0] != NTOK * DM || out_size != NTOK * DM || ws_size < WS_END) {
            fprintf(stderr, "kernel_launch: unexpected problem (n_in %d, in0 %d, out %d, ws %zu < %zu?); nothing launched\n", n_in, n_in > 0 ? in_sizes[0] : -1, out_size, ws_size, (size_t)WS_END); grid = -1; return; }
        int dev = 0, cus = 0, per_cu = 0;
        if (hipGetDevice(&dev) != hipSuccess || hipDeviceGetAttribute(&cus, hipDeviceAttributeMultiprocessorCount, dev) != hipSuccess) { grid = -1; return; }
        if (hipFuncSetAttribute((const void*)mk_fwd, hipFuncAttributeMaxDynamicSharedMemorySize, LDS_BYTES) != hipSuccess) { fprintf(stderr, "kernel_launch: hipFuncSetAttribute failed\n"); grid = -1; return; }
        if (hipOccupancyMaxActiveBlocksPerMultiprocessor(&per_cu, (const void*)mk_fwd, NTHREADS, LDS_BYTES) != hipSuccess || per_cu < 1) fprintf(stderr, "kernel_launch: occupancy query reports %d blocks per CU\n", per_cu);
        (void)hipGetLastError();
        grid = cus;
        if (grid != 256) { fprintf(stderr, "kernel_launch: this kernel is built for a 256-CU device (got %d)\n", grid); grid = -1; return; }
    }
    if (grid < 0) return;
    if (hipMemsetAsync((char*)d_ws + WS_CTL, 0, CTL_ZERO_BYTES, stream) != hipSuccess) return;
    Args a{};
    for (int i = 0; i < 31; ++i) a.in[i] = (const float*)d_in[i];
    a.out = (float*)d_out; a.ws = (unsigned char*)d_ws;
#if MK_N_LAUNCHES == 1
    a.ph_lo = 0; a.ph_hi = N_PHASES; a.use_bar = 1;
    hipLaunchKernelGGL(mk_fwd, dim3(grid), dim3(NTHREADS), LDS_BYTES, stream, a);
#else
    for (int p = 0; p < N_PHASES; ++p) { a.ph_lo = p; a.ph_hi = p + 1; a.use_bar = 0; hipLaunchKernelGGL(mk_fwd, dim3(grid), dim3(NTHREADS), LDS_BYTES, stream, a); }
#endif
}
```
